# Optimizing an MI355X kernel written in HIP

```python
import math
import jax
import jax.numpy as jnp
from jax import lax
import numpy as np

D_MODEL = 1024
BATCH = 2
SEQ = 8192
DEPTH = 2

MLA_HEADS = 8
MLA_Q_RANK = 256
MLA_KV_RANK = 128
MLA_NOPE_DIM = 64
MLA_ROPE_DIM = 32
MLA_V_DIM = 64
MLA_QK_DIM = MLA_NOPE_DIM + MLA_ROPE_DIM
ROPE_THETA = 10000.0
SWA_HEADS = 8
SWA_KV_HEADS = 2
SWA_REP = SWA_HEADS // SWA_KV_HEADS
SWA_HEAD_DIM = 64
WINDOW = 128
BLOCK = 128
REL_BUCKETS = 32
REL_MAX_DIST = 128
A_COLS = MLA_Q_RANK + MLA_KV_RANK + MLA_ROPE_DIM
B_COLS = (SWA_HEADS + 2 * SWA_KV_HEADS) * SWA_HEAD_DIM
IN0_COLS = A_COLS + B_COLS
MIX0_WIDTH = MLA_HEADS * MLA_V_DIM + SWA_HEADS * SWA_HEAD_DIM
LRU_WIDTH = D_MODEL
LRU_BLOCKS = 8
LRU_BW = LRU_WIDTH // LRU_BLOCKS
LRU_C = 8.0
CONV_WIDTH = 4
CONV_LEFT = 2
N_EXPERTS = 16
N_GROUPS = 4
EXPERTS_PER_GROUP = N_EXPERTS // N_GROUPS
TOP_K = 2
GROUP_SCORE_K = 2
D_EXPERT = 512
ALPHA = (2.0 * DEPTH) ** 0.25
BETA = (8.0 * DEPTH) ** -0.25
LN_EPS = 1e-5
RMS_EPS = 1e-6

kernel_name = 'hybrid_mla_swa_rglru_grouped_moe_encoder'


def layer_norm(x, g, b):
    xf = x.astype(jnp.float32)
    mu = jnp.mean(xf, -1, keepdims=True)
    var = jnp.mean(jnp.square(xf - mu), -1, keepdims=True)
    return ((xf - mu) * lax.rsqrt(var + LN_EPS) * g.astype(jnp.float32) + b.astype(jnp.float32)).astype(x.dtype)


def rms_norm(x, g):
    xf = x.astype(jnp.float32)
    return (xf * lax.rsqrt(jnp.mean(jnp.square(xf), -1, keepdims=True) + RMS_EPS) * g.astype(jnp.float32)).astype(x.dtype)


def rotary_tables(seq, dtype):
    half = MLA_ROPE_DIM // 2
    inv_freq = ROPE_THETA ** (-jnp.arange(half, dtype=jnp.float32) / half)
    ang = jnp.arange(seq, dtype=jnp.float32)[:, None] * inv_freq[None, :]
    return jnp.cos(ang).astype(dtype), jnp.sin(ang).astype(dtype)


def apply_rope(x, cos, sin):
    x1, x2 = jnp.split(x, 2, axis=-1)
    return jnp.concatenate([x1 * cos - x2 * sin, x1 * sin + x2 * cos], axis=-1)


def mla_attention(q_lat, kv_lat, k_rope, q_norm, w_uq, kv_norm, w_ukv, cos, sin):
    bsz, seq, _ = q_lat.shape
    q = (rms_norm(q_lat, q_norm) @ w_uq).reshape(bsz, seq, MLA_HEADS, MLA_QK_DIM)
    q = jnp.concatenate([q[..., :MLA_NOPE_DIM],
                         apply_rope(q[..., MLA_NOPE_DIM:], cos[:, None, :], sin[:, None, :])], axis=-1)
    kv = (rms_norm(kv_lat, kv_norm) @ w_ukv).reshape(bsz, seq, MLA_HEADS, MLA_NOPE_DIM + MLA_V_DIM)
    k_nope, v = kv[..., :MLA_NOPE_DIM], kv[..., MLA_NOPE_DIM:]
    k_pe = apply_rope(k_rope, cos, sin)
    k = jnp.concatenate([k_nope, jnp.broadcast_to(k_pe[:, :, None, :], (bsz, seq, MLA_HEADS, MLA_ROPE_DIM))], axis=-1)
    scale = MLA_QK_DIM ** -0.5
    n_blk = seq // BLOCK
    q_blocks = jnp.moveaxis(q.reshape(bsz, n_blk, BLOCK, MLA_HEADS, MLA_QK_DIM), 1, 0)

    def attend(qb):
        s = jnp.einsum('bqhd,bkhd->bhqk', qb, k).astype(jnp.float32) * scale
        p = jax.nn.softmax(s, axis=-1).astype(v.dtype)
        return jnp.einsum('bhqk,bkhd->bqhd', p, v)

    o = lax.map(attend, q_blocks)
    return jnp.moveaxis(o, 0, 1).reshape(bsz, seq, MLA_HEADS * MLA_V_DIM)


def t5_bucket(rel):
    n_side = REL_BUCKETS // 2
    max_exact = n_side // 2
    dist = jnp.abs(rel)
    far = max_exact + (jnp.log(jnp.maximum(dist, 1).astype(jnp.float32) / max_exact)
                       / math.log(REL_MAX_DIST / max_exact) * (n_side - max_exact)).astype(jnp.int32)
    far = jnp.minimum(far, n_side - 1)
    return jnp.where(rel > 0, n_side, 0) + jnp.where(dist < max_exact, dist, far)


def windowed_gqa(q, k, v, sinks, rel_bias):
    bsz, seq, _ = q.shape
    n_blk = seq // BLOCK
    qb = q.reshape(bsz, n_blk, BLOCK, SWA_KV_HEADS, SWA_REP, SWA_HEAD_DIM)

    def band(t):
        tp = jnp.pad(t.reshape(bsz, seq, SWA_KV_HEADS, SWA_HEAD_DIM), ((0, 0), (BLOCK, BLOCK), (0, 0), (0, 0)))
        tp = tp.reshape(bsz, n_blk + 2, BLOCK, SWA_KV_HEADS, SWA_HEAD_DIM)
        return jnp.concatenate([tp[:, :-2], tp[:, 1:-1], tp[:, 2:]], axis=2)

    kb, vb = band(k), band(v)
    s = jnp.einsum('bnqgrd,bnkgd->bgrnqk', qb, kb).astype(jnp.float32) * SWA_HEAD_DIM ** -0.5
    q_off = jnp.arange(BLOCK)
    k_off = jnp.arange(3 * BLOCK)
    rel = k_off[None, :] - BLOCK - q_off[:, None]
    bias = rel_bias.astype(jnp.float32)[t5_bucket(rel)]
    bias = jnp.transpose(bias, (2, 0, 1)).reshape(SWA_KV_HEADS, SWA_REP, 1, BLOCK, 3 * BLOCK)
    key_pos = (jnp.arange(n_blk)[:, None] - 1) * BLOCK + k_off[None, :]
    valid = (jnp.abs(rel) <= WINDOW)[None] & ((key_pos >= 0) & (key_pos < seq))[:, None, :]
    s = jnp.where(valid, s + bias, -jnp.inf)
    sink = jnp.broadcast_to(sinks.astype(jnp.float32).reshape(1, SWA_KV_HEADS, SWA_REP, 1, 1, 1), s.shape[:-1] + (1,))
    p = jax.nn.softmax(jnp.concatenate([s, sink], axis=-1), axis=-1)[..., :-1].astype(v.dtype)
    o = jnp.einsum('bgrnqk,bnkgd->bnqgrd', p, vb)
    return o.reshape(bsz, seq, SWA_HEADS * SWA_HEAD_DIM)


def mixer_attention_pair(x, w_in, q_norm, w_uq, kv_norm, w_ukv, sinks, w_out, rel_bias, cos, sin):
    proj = x @ w_in
    offs = np.cumsum([MLA_Q_RANK, MLA_KV_RANK, MLA_ROPE_DIM,
                      SWA_HEADS * SWA_HEAD_DIM, SWA_KV_HEADS * SWA_HEAD_DIM])
    q_lat, kv_lat, k_rope, q_b, k_b, v_b = jnp.split(proj, [int(o) for o in offs], axis=-1)
    out_a = mla_attention(q_lat, kv_lat, k_rope, q_norm, w_uq, kv_norm, w_ukv, cos, sin)
    out_b = windowed_gqa(q_b, k_b, v_b, sinks, rel_bias)
    return jnp.concatenate([out_a, out_b], axis=-1) @ w_out


def block_diag_linear(x, w, b):
    xb = x.reshape(x.shape[:-1] + (LRU_BLOCKS, LRU_BW))
    return (jnp.einsum('bsnc,ncd->bsnd', xb, w) + b).reshape(x.shape)


def rg_lru(xc, w_a, b_a, w_x, b_x, lam, reverse):
    f32 = jnp.float32
    r = jax.nn.sigmoid(block_diag_linear(xc, w_a.astype(f32), b_a.astype(f32)))
    i = jax.nn.sigmoid(block_diag_linear(xc, w_x.astype(f32), b_x.astype(f32)))
    log_a = LRU_C * r * jax.nn.log_sigmoid(lam.astype(f32))
    a = jnp.exp(log_a)
    b = jnp.sqrt(-jnp.expm1(2.0 * log_a)) * (i * xc)

    def combine(c1, c2):
        a1, b1 = c1
        a2, b2 = c2
        return a1 * a2, a2 * b1 + b2

    _, h = lax.associative_scan(combine, (a, b), reverse=reverse, axis=1)
    return h


def mixer_rglru(x, w_in, conv_w, conv_b, wa_f, ba_f, wx_f, bx_f, lam_f,
                wa_b, ba_b, wx_b, bx_b, lam_b, w_out):
    seq = x.shape[1]
    gate, xr = jnp.split(x @ w_in, 2, axis=-1)
    xp = jnp.pad(xr, ((0, 0), (CONV_LEFT, CONV_WIDTH - 1 - CONV_LEFT), (0, 0)))
    xc = conv_b + sum(xp[:, k:k + seq] * conv_w[k] for k in range(CONV_WIDTH))
    xc = xc.astype(jnp.float32)
    h = (rg_lru(xc, wa_f, ba_f, wx_f, bx_f, lam_f, False)
         + rg_lru(xc, wa_b, ba_b, wx_b, bx_b, lam_b, True))
    y = h.astype(x.dtype) * jax.nn.gelu(gate, approximate=True)
    return y @ w_out


def grouped_moe(x, router_w, router_bias, w1, w3, w2):
    f32 = jnp.float32
    bsz, seq, d = x.shape
    t = x.reshape(bsz * seq, d)
    scores = jax.nn.sigmoid(t.astype(f32) @ router_w.astype(f32))
    biased = scores + router_bias.astype(f32)
    group_score = lax.top_k(biased.reshape(-1, N_GROUPS, EXPERTS_PER_GROUP), GROUP_SCORE_K)[0].sum(-1)
    group_mask = jnp.argmax(group_score, axis=-1)[:, None] == jnp.arange(N_GROUPS)[None, :]
    expert_mask = jnp.repeat(group_mask, EXPERTS_PER_GROUP, axis=-1)
    _, idx = lax.top_k(jnp.where(expert_mask, biased, -jnp.inf), TOP_K)
    w = jnp.take_along_axis(scores, idx, axis=-1)
    w = w / jnp.sum(w, axis=-1, keepdims=True)
    gates = jnp.einsum('tk,tke->te', w, jax.nn.one_hot(idx, N_EXPERTS, dtype=f32)).astype(x.dtype)
    y = jnp.zeros_like(t)
    for e in range(N_EXPERTS):
        h = jax.nn.silu(t @ w1[e]) * (t @ w3[e])
        y = y + gates[:, e:e + 1] * (h @ w2[e])
    return y.reshape(bsz, seq, d)


def setup_inputs(seed: int = 0) -> dict:
    key = jax.random.key(seed)
    ks = iter(jax.random.split(key, 48))
    f32 = jnp.float32
    D = D_MODEL

    def nrm(shape, scale):
        return jax.random.normal(next(ks), shape, f32) * scale

    def gain(n):
        return 1.0 + nrm((n,), 0.01)

    def lru_lambda():
        u = jax.random.uniform(next(ks), (LRU_WIDTH,), f32, minval=0.9, maxval=0.999)
        a = u ** (1.0 / LRU_C)
        return jnp.log(a) - jnp.log1p(-a)

    inp = {}
    inp['x'] = nrm((BATCH, SEQ, D), 1.0)
    inp['rel_bias'] = nrm((REL_BUCKETS, SWA_HEADS), 0.2)
    inp['router_w'] = nrm((D, N_EXPERTS), D ** -0.5)
    inp['router_bias'] = nrm((N_EXPERTS,), 0.01)
    inp['l0_w_in'] = nrm((D, IN0_COLS), D ** -0.5)
    inp['l0_q_norm'] = gain(MLA_Q_RANK)
    inp['l0_w_uq'] = nrm((MLA_Q_RANK, MLA_HEADS * MLA_QK_DIM), MLA_Q_RANK ** -0.5)
    inp['l0_kv_norm'] = gain(MLA_KV_RANK)
    inp['l0_w_ukv'] = nrm((MLA_KV_RANK, MLA_HEADS * (MLA_NOPE_DIM + MLA_V_DIM)), MLA_KV_RANK ** -0.5)
    inp['l0_sinks'] = nrm((SWA_HEADS,), 0.5)
    inp['l0_w_out'] = nrm((MIX0_WIDTH, D), MIX0_WIDTH ** -0.5 * BETA)
    inp['l0_ln1_g'] = gain(D)
    inp['l0_ln1_b'] = nrm((D,), 0.01)
    inp['l0_w1'] = nrm((N_EXPERTS, D, D_EXPERT), D ** -0.5)
    inp['l0_w3'] = nrm((N_EXPERTS, D, D_EXPERT), D ** -0.5)
    inp['l0_w2'] = nrm((N_EXPERTS, D_EXPERT, D), D_EXPERT ** -0.5 * BETA)
    inp['l0_ln2_g'] = gain(D)
    inp['l0_ln2_b'] = nrm((D,), 0.01)
    inp['l1_w_in'] = nrm((D, 2 * LRU_WIDTH), D ** -0.5)
    inp['l1_conv_w'] = nrm((CONV_WIDTH, LRU_WIDTH), CONV_WIDTH ** -0.5)
    inp['l1_conv_b'] = nrm((LRU_WIDTH,), 0.01)
    inp['l1_wa_f'] = nrm((LRU_BLOCKS, LRU_BW, LRU_BW), LRU_BW ** -0.5)
    inp['l1_ba_f'] = nrm((LRU_BLOCKS, LRU_BW), 0.01)
    inp['l1_wx_f'] = nrm((LRU_BLOCKS, LRU_BW, LRU_BW), LRU_BW ** -0.5)
    inp['l1_bx_f'] = nrm((LRU_BLOCKS, LRU_BW), 0.01)
    inp['l1_lam_f'] = lru_lambda()
    inp['l1_wa_b'] = nrm((LRU_BLOCKS, LRU_BW, LRU_BW), LRU_BW ** -0.5)
    inp['l1_ba_b'] = nrm((LRU_BLOCKS, LRU_BW), 0.01)
    inp['l1_wx_b'] = nrm((LRU_BLOCKS, LRU_BW, LRU_BW), LRU_BW ** -0.5)
    inp['l1_bx_b'] = nrm((LRU_BLOCKS, LRU_BW), 0.01)
    inp['l1_lam_b'] = lru_lambda()
    inp['l1_w_out'] = nrm((LRU_WIDTH, D), LRU_WIDTH ** -0.5 * BETA)
    inp['l1_ln1_g'] = gain(D)
    inp['l1_ln1_b'] = nrm((D,), 0.01)
    inp['l1_w1'] = nrm((N_EXPERTS, D, D_EXPERT), D ** -0.5)
    inp['l1_w3'] = nrm((N_EXPERTS, D, D_EXPERT), D ** -0.5)
    inp['l1_w2'] = nrm((N_EXPERTS, D_EXPERT, D), D_EXPERT ** -0.5 * BETA)
    inp['l1_ln2_g'] = gain(D)
    inp['l1_ln2_b'] = nrm((D,), 0.01)
    return inp


def reference(x, rel_bias, router_w, router_bias,
              l0_w_in, l0_q_norm, l0_w_uq, l0_kv_norm, l0_w_ukv, l0_sinks, l0_w_out,
              l0_ln1_g, l0_ln1_b, l0_w1, l0_w3, l0_w2, l0_ln2_g, l0_ln2_b,
              l1_w_in, l1_conv_w, l1_conv_b, l1_wa_f, l1_ba_f, l1_wx_f, l1_bx_f, l1_lam_f,
              l1_wa_b, l1_ba_b, l1_wx_b, l1_bx_b, l1_lam_b, l1_w_out,
              l1_ln1_g, l1_ln1_b, l1_w1, l1_w3, l1_w2, l1_ln2_g, l1_ln2_b):
    cos, sin = rotary_tables(x.shape[1], x.dtype)
    mixer_params = [
        (l0_w_in, l0_q_norm, l0_w_uq, l0_kv_norm, l0_w_ukv, l0_sinks, l0_w_out),
        (l1_w_in, l1_conv_w, l1_conv_b, l1_wa_f, l1_ba_f, l1_wx_f, l1_bx_f, l1_lam_f,
         l1_wa_b, l1_ba_b, l1_wx_b, l1_bx_b, l1_lam_b, l1_w_out),
    ]
    norm1 = [(l0_ln1_g, l0_ln1_b), (l1_ln1_g, l1_ln1_b)]
    experts = [(l0_w1, l0_w3, l0_w2), (l1_w1, l1_w3, l1_w2)]
    norm2 = [(l0_ln2_g, l0_ln2_b), (l1_ln2_g, l1_ln2_b)]
    h = x
    for layer in range(DEPTH):
        if layer % 2 == 0:
            mixed = mixer_attention_pair(h, *mixer_params[layer], rel_bias, cos, sin)
        else:
            mixed = mixer_rglru(h, *mixer_params[layer])
        h = layer_norm(ALPHA * h + mixed, *norm1[layer])
        h = layer_norm(ALPHA * h + grouped_moe(h, router_w, router_bias, *experts[layer]), *norm2[layer])
    return h
```

```cpp
#include <hip/hip_runtime.h>
#include <hip/hip_cooperative_groups.h>
#include <stdint.h>
#include <stdio.h>

namespace {
typedef unsigned short bf16_t;
typedef short bf16x8 __attribute__((ext_vector_type(8)));
typedef short s16x4 __attribute__((ext_vector_type(4)));
typedef float f32x4 __attribute__((ext_vector_type(4)));
typedef float f32x16 __attribute__((ext_vector_type(16)));
typedef unsigned u32x2 __attribute__((ext_vector_type(2)));
typedef unsigned u32x4 __attribute__((ext_vector_type(4)));
#define LAS __attribute__((address_space(3)))

constexpr int T = 16384, S = 8192, D = 1024;
constexpr int NTHR = 512;
constexpr size_t MiB = (size_t)1 << 20;
constexpr float LOG2E = 1.4426950408889634f;
constexpr float ALPHA = 1.4142135623730951f;
constexpr float LN_EPS = 1e-5f, RMS_EPS = 1e-6f;
constexpr float QSCALE_MLA = 0.10206207261596575f * LOG2E;
constexpr float QSCALE_SWA = 0.125f * LOG2E;

constexpr size_t OFF_MISC = 0;
constexpr size_t OFF_WS   = 4 * MiB;
constexpr size_t OFF_WMOE = 17 * MiB;
constexpr size_t OFF_RA   = 65 * MiB;
constexpr size_t OFF_RF   = 97 * MiB;
constexpr size_t OFF_RS   = 161 * MiB;
constexpr size_t WS_NEED  = 279 * MiB;
constexpr size_t M_CNT   = 0;
constexpr size_t M_BAR   = 4096;
constexpr size_t M_BIAS  = 64 * 1024;
constexpr size_t M_SSQQ  = 128 * 1024;
constexpr size_t M_SSQKV = 384 * 1024;
constexpr size_t M_GATEW = 512 * 1024;
constexpr size_t M_ROPE  = 1 * MiB;
constexpr size_t M_LIST  = 2 * MiB;
constexpr size_t W_IN0  = 0;
constexpr size_t W_UQ   = 2560 * 1024;
constexpr size_t W_UKV  = W_UQ + 768 * 256 * 2;
constexpr size_t W_OUT0 = W_UKV + 1024 * 128 * 2;
constexpr size_t W_IN1  = W_OUT0 + 2 * MiB;
constexpr size_t W_GATE = W_IN1 + 4 * MiB;
constexpr size_t W_OUT1 = W_GATE + 1 * MiB;
constexpr size_t W_UP = 0;
constexpr size_t W_DN = 32 * MiB;
constexpr size_t S_QLAT = 0, S_KVLAT = 8 * MiB, S_QB = 12 * MiB, S_KB = 28 * MiB, S_VB = 32 * MiB, S_V = 36 * MiB, S_CAT = 52 * MiB;
constexpr size_t S_HMOE = 0, S_Y = 32 * MiB;
constexpr size_t S_GG = 0, S_XR = 32 * MiB, S_XC = 64 * MiB, S_AGGF = 96 * MiB, S_AGGB = 98 * MiB, S_CARF = 100 * MiB, S_CARB = 101 * MiB;

struct Params {
    const float *x, *rel_bias, *router_w, *router_bias;
    const float *l0_w_in, *l0_q_norm, *l0_w_uq, *l0_kv_norm, *l0_w_ukv, *l0_sinks, *l0_w_out, *l0_ln1_g, *l0_ln1_b, *l0_w1, *l0_w3, *l0_w2, *l0_ln2_g, *l0_ln2_b;
    const float *l1_w_in, *l1_conv_w, *l1_conv_b, *l1_wa_f, *l1_ba_f, *l1_wx_f, *l1_bx_f, *l1_lam_f, *l1_wa_b, *l1_ba_b, *l1_wx_b, *l1_bx_b, *l1_lam_b, *l1_w_out,
                *l1_ln1_g, *l1_ln1_b, *l1_w1, *l1_w3, *l1_w2, *l1_ln2_g, *l1_ln2_b;
    float* out;
    char* ws;
};

__device__ __forceinline__ float bf2f(bf16_t v) { return __uint_as_float((unsigned)v << 16); }
__device__ __forceinline__ bf16_t f2bf(float f) { unsigned u = __float_as_uint(f); u += 0x7fffu + ((u >> 16) & 1u); return (bf16_t)(u >> 16); }
__device__ __forceinline__ unsigned pk2(float lo, float hi) { unsigned r; asm("v_cvt_pk_bf16_f32 %0, %1, %2" : "=v"(r) : "v"(lo), "v"(hi)); return r; }
__device__ __forceinline__ u32x2 pk4(f32x4 v) { u32x2 r; r.x = pk2(v[0], v[1]); r.y = pk2(v[2], v[3]); return r; }
__device__ __forceinline__ float sigmoidf_(float x) { return 1.0f / (1.0f + __expf(-x)); }
__device__ __forceinline__ float wave_sum(float v) {
#pragma unroll
    for (int o = 32; o >= 1; o >>= 1) v += __shfl_xor(v, o);
    return v;
}
__device__ __forceinline__ int crow(int r, int hi) { return (r & 3) + 8 * (r >> 2) + 4 * hi; }
#define MFMA16(a, b, c) __builtin_amdgcn_mfma_f32_16x16x32_bf16(a, b, c, 0, 0, 0)
#define MFMA32(a, b, c) __builtin_amdgcn_mfma_f32_32x32x16_bf16(a, b, c, 0, 0, 0)

constexpr int G_A_BYTES = 256 * 128, G_B_BYTES = 128 * 128, G_STAGE = G_A_BYTES + G_B_BYTES;
constexpr int LDS_BYTES = 131072;

struct ARows { const bf16_t* p[4]; };

template <class Epi>
__device__ __forceinline__ void gemm_tile(char* lds, const ARows& ar, const bf16_t* Bt, int ldb, int K, const Epi& epi) {
    const int tid = threadIdx.x, lane = tid & 63, wid = tid >> 6, wm = wid >> 1, wn = wid & 1, fr = lane & 15, fq = lane >> 4;
    const int srow = tid >> 3, skc = tid & 7;
    const int st_off = srow * 128 + ((skc ^ (srow & 7)) << 4);
    const bf16_t* bp0 = Bt + (size_t)srow * ldb + skc * 8;
    const bf16_t* bp1 = Bt + (size_t)(srow + 64) * ldb + skc * 8;
    const int kofs = skc * 8;
    f32x4 acc[4][4];
#pragma unroll
    for (int m = 0; m < 4; ++m)
#pragma unroll
        for (int n = 0; n < 4; ++n) acc[m][n] = (f32x4){0.f, 0.f, 0.f, 0.f};
    u32x4 ra[4], rb[2];
    const int nk = K >> 6;
#pragma unroll
    for (int i = 0; i < 4; ++i) ra[i] = *(const u32x4*)(ar.p[i] + kofs);
    rb[0] = *(const u32x4*)bp0; rb[1] = *(const u32x4*)bp1;
#pragma unroll
    for (int i = 0; i < 4; ++i) *(u32x4*)(lds + st_off + i * 8192) = ra[i];
    *(u32x4*)(lds + G_A_BYTES + st_off) = rb[0]; *(u32x4*)(lds + G_A_BYTES + st_off + 8192) = rb[1];
    __syncthreads();
    const int fa = (wm * 64 + fr) * 128, fb = G_A_BYTES + (wn * 64 + fr) * 128;
    const int c0 = ((fq ^ (fr & 7)) << 4), c1 = (((4 + fq) ^ (fr & 7)) << 4);
#pragma unroll 1
    for (int kt = 0; kt < nk; ++kt) {
        char* cur = lds + (kt & 1) * G_STAGE;
        char* nxt = lds + ((kt + 1) & 1) * G_STAGE;
        const bool more = (kt + 1 < nk);
        if (more) {
            const int ko = (kt + 1) * 64;
#pragma unroll
            for (int i = 0; i < 4; ++i) ra[i] = *(const u32x4*)(ar.p[i] + ko + kofs);
            rb[0] = *(const u32x4*)(bp0 + ko); rb[1] = *(const u32x4*)(bp1 + ko);
        }
#pragma unroll
        for (int kk = 0; kk < 2; ++kk) {
            const int cc = kk ? c1 : c0;
            bf16x8 af[4], bfr[4];
#pragma unroll
            for (int m = 0; m < 4; ++m) af[m] = *(const bf16x8*)(cur + fa + m * 2048 + cc);
#pragma unroll
            for (int n = 0; n < 4; ++n) bfr[n] = *(const bf16x8*)(cur + fb + n * 2048 + cc);
#pragma unroll
            for (int m = 0; m < 4; ++m)
#pragma unroll
                for (int n = 0; n < 4; ++n) acc[m][n] = MFMA16(bfr[n], af[m], acc[m][n]);
        }
        if (more) {
#pragma unroll
            for (int i = 0; i < 4; ++i) *(u32x4*)(nxt + st_off + i * 8192) = ra[i];
            *(u32x4*)(nxt + G_A_BYTES + st_off) = rb[0]; *(u32x4*)(nxt + G_A_BYTES + st_off + 8192) = rb[1];
        }
        __syncthreads();
    }
    epi(acc, wm, wn, fr, fq);
}

__device__ __forceinline__ ARows plain_rows(const bf16_t* A, int lda, int m0) {
    ARows r; const int srow = threadIdx.x >> 3;
#pragma unroll
    for (int i = 0; i < 4; ++i) r.p[i] = A + (size_t)(m0 + srow + 64 * i) * lda;
    return r;
}

__device__ __forceinline__ int nmap(int mode, int n) {
    switch (mode) {
        case 1: return n < 384 ? n : (n < 416 ? 1152 + (n - 384) : (n - 416 + 384));
        case 2: { const int h = n / 96, d = n - h * 96; return d < 64 ? h * 64 + d : (d < 80 ? 512 + h * 32 + (d - 64) : 512 + h * 32 + 16 + (d - 80)); }
        case 3: return (n >> 4) * 32 + (n & 15);
        case 4: return (n >> 4) * 32 + 16 + (n & 15);
        default: return n;
    }
}
__device__ __forceinline__ void tconv_tile(char* lds, const float* src, int lds_src, int N, bf16_t* dst, int ldd, int k0, int n0, int mode, const float* ks) {
    float* t = (float*)lds;
    const int tid = threadIdx.x;
#pragma unroll
    for (int i = 0; i < 2; ++i) {
        const int k = (tid >> 4) + 32 * i, nl = (tid & 15) * 4, n = n0 + nl;
        f32x4 v = (f32x4){0.f, 0.f, 0.f, 0.f};
        if (n < N) v = *(const f32x4*)(src + (size_t)(k0 + k) * lds_src + n);
        if (ks) v = v * ks[k0 + k];
#pragma unroll
        for (int j = 0; j < 4; ++j) t[(nl + j) * 65 + k] = v[j];
    }
    __syncthreads();
    {
        const int nl = tid >> 3, kc = (tid & 7) * 8, n = n0 + nl;
        if (n < N) {
            const float* s = t + nl * 65 + kc;
            u32x4 w; w.x = pk2(s[0], s[1]); w.y = pk2(s[2], s[3]); w.z = pk2(s[4], s[5]); w.w = pk2(s[6], s[7]);
            *(u32x4*)(dst + (size_t)nmap(mode, n) * ldd + k0 + kc) = w;
        }
    }
    __syncthreads();
}
__device__ __forceinline__ void tconv_job(char* lds, int local, const float* src, bf16_t* dst, int K, int N, int ldd, int mode, const float* ks, size_t sbs, size_t dbs) {
    const int nkt = K >> 6, nnt = (N + 63) >> 6, per = nkt * nnt;
    const int b = local / per, r = local - b * per, kt = r / nnt, nt = r - kt * nnt;
    tconv_tile(lds, src + (size_t)b * sbs, N, N, dst + (size_t)b * dbs, ldd, kt * 64, nt * 64, mode, ks);
}
constexpr int TC_IN0 = 16 * 19, TC_UQ = 4 * 12, TC_UKV = 2 * 16, TC_SQ = 256, TC_IN1 = 16 * 32, TC_GATE = 8 * 4, TC_MOE = 16 * 128;
constexpr int TC_SMALL = TC_IN0 + TC_UQ + TC_UKV + TC_SQ + TC_IN1 + 4 * TC_GATE + TC_SQ;

__device__ void conv_small(const Params& p, char* lds, int id) {
    bf16_t* w = (bf16_t*)(p.ws + OFF_WS);
    if (id < TC_IN0) { tconv_job(lds, id, p.l0_w_in, w + W_IN0 / 2, 1024, 1184, 1024, 1, nullptr, 0, 0); return; } id -= TC_IN0;
    if (id < TC_UQ) { tconv_job(lds, id, p.l0_w_uq, w + W_UQ / 2, 256, 768, 256, 2, p.l0_q_norm, 0, 0); return; } id -= TC_UQ;
    if (id < TC_UKV) { tconv_job(lds, id, p.l0_w_ukv, w + W_UKV / 2, 128, 1024, 128, 0, p.l0_kv_norm, 0, 0); return; } id -= TC_UKV;
    if (id < TC_SQ) { tconv_job(lds, id, p.l0_w_out, w + W_OUT0 / 2, 1024, 1024, 1024, 0, nullptr, 0, 0); return; } id -= TC_SQ;
    if (id < TC_IN1) { tconv_job(lds, id, p.l1_w_in, w + W_IN1 / 2, 1024, 2048, 1024, 0, nullptr, 0, 0); return; } id -= TC_IN1;
    if (id < TC_GATE) { tconv_job(lds, id, p.l1_wa_f, w + W_GATE / 2, 128, 128, 128, 0, nullptr, 16384, 16384); return; } id -= TC_GATE;
    if (id < TC_GATE) { tconv_job(lds, id, p.l1_wx_f, w + W_GATE / 2 + 131072, 128, 128, 128, 0, nullptr, 16384, 16384); return; } id -= TC_GATE;
    if (id < TC_GATE) { tconv_job(lds, id, p.l1_wa_b, w + W_GATE / 2 + 2 * 131072, 128, 128, 128, 0, nullptr, 16384, 16384); return; } id -= TC_GATE;
    if (id < TC_GATE) { tconv_job(lds, id, p.l1_wx_b, w + W_GATE / 2 + 3 * 131072, 128, 128, 128, 0, nullptr, 16384, 16384); return; } id -= TC_GATE;
    tconv_job(lds, id, p.l1_w_out, w + W_OUT1 / 2, 1024, 1024, 1024, 0, nullptr, 0, 0);
}
__device__ void conv_moe(const Params& p, char* lds, int id, int layer) {
    bf16_t* w = (bf16_t*)(p.ws + OFF_WMOE);
    const float* w1 = layer ? p.l1_w1 : p.l0_w1; const float* w3 = layer ? p.l1_w3 : p.l0_w3; const float* w2 = layer ? p.l1_w2 : p.l0_w2;
    if (id < TC_MOE) { tconv_job(lds, id, w1, w + W_UP / 2, 1024, 512, 1024, 3, nullptr, (size_t)1024 * 512, (size_t)1024 * 1024); return; } id -= TC_MOE;
    if (id < TC_MOE) { tconv_job(lds, id, w3, w + W_UP / 2, 1024, 512, 1024, 4, nullptr, (size_t)1024 * 512, (size_t)1024 * 1024); return; } id -= TC_MOE;
    tconv_job(lds, id, w2, w + W_DN / 2, 512, 1024, 512, 0, nullptr, (size_t)512 * 1024, (size_t)1024 * 512);
}

__device__ void phase_prologue(const Params& p, char* lds) {
    const int nb = gridDim.x, bid = blockIdx.x, tid = threadIdx.x;
    const int gtid = bid * NTHR + tid, gsz = nb * NTHR;
    {
        bf16_t* xb = (bf16_t*)(p.ws + OFF_RA);
        for (int i = gtid; i < T * D / 8; i += gsz) {
            const f32x4 a = *(const f32x4*)(p.x + (size_t)i * 8), b = *(const f32x4*)(p.x + (size_t)i * 8 + 4);
            u32x4 w; w.x = pk2(a[0], a[1]); w.y = pk2(a[2], a[3]); w.z = pk2(b[0], b[1]); w.w = pk2(b[2], b[3]);
            *(u32x4*)(xb + (size_t)i * 8) = w;
        }
    }
    {
        float2* rt = (float2*)(p.ws + OFF_MISC + M_ROPE);
        for (int i = gtid; i < S * 16; i += gsz) {
            const int pos = i >> 4, j = i & 15;
            const float inv = powf(10000.0f, -(float)j / 16.0f);
            const float ang = (float)pos * inv;
            float sn, cs; sincosf(ang, &sn, &cs);
            rt[i] = make_float2(cs, sn);
        }
    }
    {
        float* bt = (float*)(p.ws + OFF_MISC + M_BIAS);
        for (int i = gtid; i < 8 * 257; i += gsz) {
            const int h = i / 257, rel = (i - h * 257) - 128, dist = rel < 0 ? -rel : rel;
            int bucket;
            if (dist < 8) bucket = dist;
            else { int far = 2 + (31 - __clz(dist * dist)); bucket = far < 15 ? far : 15; }
            if (rel > 0) bucket += 16;
            bt[i] = p.rel_bias[bucket * 8 + h] * LOG2E;
        }
    }
    {
        u32x4* z = (u32x4*)(p.ws + OFF_WS + W_IN0 + (size_t)1184 * 1024 * 2);
        for (int i = gtid; i < 96 * 1024 * 2 / 16; i += gsz) z[i] = (u32x4){0u, 0u, 0u, 0u};
    }
    for (int id = bid; id < TC_SMALL + 3 * TC_MOE; id += nb) {
        if (id < TC_SMALL) conv_small(p, lds, id); else conv_moe(p, lds, id - TC_SMALL, 0);
    }
}

struct EpiIn0 {
    const Params& p; int m0, nt;
    __device__ __forceinline__ void operator()(f32x4 (&acc)[4][4], int wm, int wn, int fr, int fq) const {
        char* rs = p.ws + OFF_RS;
#pragma unroll
        for (int m = 0; m < 4; ++m) {
            const int row = m0 + wm * 64 + m * 16 + fr;
            if (nt <= 2) {
                float ss = 0.f;
                bf16_t* dst = nt < 2 ? (bf16_t*)(rs + S_QLAT) + (size_t)row * 256 + nt * 128 + wn * 64 + fq * 4 : (bf16_t*)(rs + S_KVLAT) + (size_t)row * 128 + wn * 64 + fq * 4;
#pragma unroll
                for (int n = 0; n < 4; ++n) { const f32x4 v = acc[m][n]; ss += v[0] * v[0] + v[1] * v[1] + v[2] * v[2] + v[3] * v[3]; *(u32x2*)(dst + n * 16) = pk4(v); }
                ss += __shfl_xor(ss, 16); ss += __shfl_xor(ss, 32);
                if (fq == 0) { if (nt < 2) ((float*)(p.ws + OFF_MISC + M_SSQQ))[row * 4 + nt * 2 + wn] = ss; else ((float*)(p.ws + OFF_MISC + M_SSQKV))[row * 2 + wn] = ss; }
            } else if (nt <= 6) {
                bf16_t* dst = (bf16_t*)(rs + S_QB) + (size_t)row * 512 + (nt - 3) * 128 + wn * 64 + fq * 4;
#pragma unroll
                for (int n = 0; n < 4; ++n) *(u32x2*)(dst + n * 16) = pk4(acc[m][n] * QSCALE_SWA);
            } else if (nt <= 8) {
                bf16_t* dst = (bf16_t*)(rs + (nt == 7 ? S_KB : S_VB)) + (size_t)row * 128 + wn * 64 + fq * 4;
#pragma unroll
                for (int n = 0; n < 4; ++n) *(u32x2*)(dst + n * 16) = pk4(acc[m][n]);
            } else if (wn == 0) {
                const int pos = row & (S - 1);
                const float2* rt = (const float2*)(p.ws + OFF_MISC + M_ROPE) + pos * 16 + fq * 4;
                f32x4 o1, o2;
#pragma unroll
                for (int r = 0; r < 4; ++r) { const float2 cs = rt[r]; const float x1 = acc[m][0][r], x2 = acc[m][1][r]; o1[r] = x1 * cs.x - x2 * cs.y; o2[r] = x1 * cs.y + x2 * cs.x; }
                bf16_t* kd = (bf16_t*)((char*)p.out + 24 * MiB) + (size_t)row * 768 + 64 + fq * 4;
                const u32x2 w1 = pk4(o1), w2 = pk4(o2);
#pragma unroll
                for (int h = 0; h < 8; ++h) { *(u32x2*)(kd + h * 96) = w1; *(u32x2*)(kd + h * 96 + 16) = w2; }
            }
        }
    }
};
__device__ void phase_in0(const Params& p, char* lds) {
    const bf16_t* xb = (const bf16_t*)(p.ws + OFF_RA);
    const bf16_t* w = (const bf16_t*)(p.ws + OFF_WS + W_IN0);
    for (int ti = blockIdx.x; ti < 64 * 10; ti += gridDim.x) {
        const int mt = ti / 10, nt = ti - mt * 10;
        EpiIn0 e{p, mt * 256, nt};
        gemm_tile(lds, plain_rows(xb, 1024, mt * 256), w + (size_t)nt * 128 * 1024, 1024, 1024, e);
    }
}

struct EpiQup {
    const Params& p; int m0, nt;
    __device__ __forceinline__ void operator()(f32x4 (&acc)[4][4], int wm, int wn, int fr, int fq) const {
        bf16_t* Q = (bf16_t*)p.out;
        const float* ssq = (const float*)(p.ws + OFF_MISC + M_SSQQ);
#pragma unroll
        for (int m = 0; m < 4; ++m) {
            const int row = m0 + wm * 64 + m * 16 + fr;
            const f32x4 s4 = *(const f32x4*)(ssq + row * 4);
            const float sc = rsqrtf(((s4[0] + s4[1]) + (s4[2] + s4[3])) * (1.0f / 256.0f) + RMS_EPS) * QSCALE_MLA;
            if (nt < 4) {
                bf16_t* dst = Q + (size_t)row * 768 + (nt * 2 + wn) * 96 + fq * 4;
#pragma unroll
                for (int n = 0; n < 4; ++n) *(u32x2*)(dst + n * 16) = pk4(acc[m][n] * sc);
            } else {
                const int pos = row & (S - 1);
                const float2* rt = (const float2*)(p.ws + OFF_MISC + M_ROPE) + pos * 16 + fq * 4;
#pragma unroll
                for (int pr = 0; pr < 2; ++pr) {
                    const int h = (nt - 4) * 4 + wn * 2 + pr;
                    f32x4 o1, o2;
#pragma unroll
                    for (int r = 0; r < 4; ++r) { const float2 cs = rt[r]; const float x1 = acc[m][2 * pr][r] * sc, x2 = acc[m][2 * pr + 1][r] * sc; o1[r] = x1 * cs.x - x2 * cs.y; o2[r] = x1 * cs.y + x2 * cs.x; }
                    bf16_t* dst = Q + (size_t)row * 768 + h * 96 + 64 + fq * 4;
                    *(u32x2*)dst = pk4(o1); *(u32x2*)(dst + 16) = pk4(o2);
                }
            }
        }
    }
};
struct EpiKVup {
    const Params& p; int m0, nt;
    __device__ __forceinline__ void operator()(f32x4 (&acc)[4][4], int wm, int wn, int fr, int fq) const {
        bf16_t* Kb = (bf16_t*)((char*)p.out + 24 * MiB);
        bf16_t* Vb = (bf16_t*)(p.ws + OFF_RS + S_V);
        const float* ssq = (const float*)(p.ws + OFF_MISC + M_SSQKV);
#pragma unroll
        for (int m = 0; m < 4; ++m) {
            const int row = m0 + wm * 64 + m * 16 + fr;
            const float sc = rsqrtf((ssq[row * 2] + ssq[row * 2 + 1]) * (1.0f / 128.0f) + RMS_EPS);
            bf16_t* dst = wn == 0 ? Kb + (size_t)row * 768 + nt * 96 + fq * 4 : Vb + (size_t)row * 512 + nt * 64 + fq * 4;
#pragma unroll
            for (int n = 0; n < 4; ++n) *(u32x2*)(dst + n * 16) = pk4(acc[m][n] * sc);
        }
    }
};
__device__ void phase_up(const Params& p, char* lds) {
    const bf16_t* qlat = (const bf16_t*)(p.ws + OFF_RS + S_QLAT);
    const bf16_t* kvlat = (const bf16_t*)(p.ws + OFF_RS + S_KVLAT);
    const bf16_t* wuq = (const bf16_t*)(p.ws + OFF_WS + W_UQ);
    const bf16_t* wukv = (const bf16_t*)(p.ws + OFF_WS + W_UKV);
    for (int ti = blockIdx.x; ti < 64 * 14; ti += gridDim.x) {
        const int mt = ti / 14, r = ti - mt * 14;
        if (r < 6) { EpiQup e{p, mt * 256, r}; gemm_tile(lds, plain_rows(qlat, 256, mt * 256), wuq + (size_t)r * 128 * 256, 256, 256, e); }
        else { EpiKVup e{p, mt * 256, r - 6}; gemm_tile(lds, plain_rows(kvlat, 128, mt * 256), wukv + (size_t)(r - 6) * 128 * 128, 128, 128, e); }
    }
}

__device__ __forceinline__ s16x4 vtr(const char* pl) {
    typedef short v4i16_t __attribute__((ext_vector_type(4)));
    return __builtin_bit_cast(s16x4, __builtin_amdgcn_ds_read_tr16_b64_v4i16((LAS v4i16_t*)(LAS char*)pl));
}
__device__ __forceinline__ void softmax_pv(f32x16& s0, f32x16& s1, float& mrun, float& lrun, f32x16 (&o)[2], const char* vt, int dstride, float* af, int lane) {
    const int r32 = lane & 31, hi = lane >> 5;
    float mx = s0[0];
#pragma unroll
    for (int r = 1; r < 16; ++r) mx = fmaxf(mx, s0[r]);
#pragma unroll
    for (int r = 0; r < 16; ++r) mx = fmaxf(mx, s1[r]);
    mx = fmaxf(mx, __shfl_xor(mx, 32));
    const float mnew = fmaxf(mrun, mx);
    const float alpha = __builtin_amdgcn_exp2f(mrun - mnew);
    mrun = mnew;
    float ls = 0.f;
#pragma unroll
    for (int r = 0; r < 16; ++r) { s0[r] = __builtin_amdgcn_exp2f(s0[r] - mnew); s1[r] = __builtin_amdgcn_exp2f(s1[r] - mnew); ls += s0[r] + s1[r]; }
    lrun = lrun * alpha + ls;
    if (hi == 0) af[r32] = alpha;
    bf16x8 pw[4];
#pragma unroll
    for (int s = 0; s < 4; ++s) {
        u32x4 w;
        if (s < 2) { w.x = pk2(s0[8 * s], s0[8 * s + 1]); w.y = pk2(s0[8 * s + 2], s0[8 * s + 3]); w.z = pk2(s0[8 * s + 4], s0[8 * s + 5]); w.w = pk2(s0[8 * s + 6], s0[8 * s + 7]); }
        else { const int q = s - 2; w.x = pk2(s1[8 * q], s1[8 * q + 1]); w.y = pk2(s1[8 * q + 2], s1[8 * q + 3]); w.z = pk2(s1[8 * q + 4], s1[8 * q + 5]); w.w = pk2(s1[8 * q + 6], s1[8 * q + 7]); }
        pw[s] = __builtin_bit_cast(bf16x8, w);
    }
#pragma unroll
    for (int r = 0; r < 16; ++r) { const float a = af[crow(r, hi)]; o[0][r] *= a; o[1][r] *= a; }
    const char* vp = vt + ((lane >> 4) & 1) * 32 + (lane & 3) * 8 + (4 * hi + ((lane & 15) >> 2)) * 64;
#pragma unroll
    for (int d0 = 0; d0 < 2; ++d0)
#pragma unroll
        for (int s = 0; s < 4; ++s) {
            const s16x4 lo = vtr(vp + d0 * dstride + s * 1024), hh = vtr(vp + d0 * dstride + s * 1024 + 512);
            const bf16x8 vf = (bf16x8){lo[0], lo[1], lo[2], lo[3], hh[0], hh[1], hh[2], hh[3]};
            o[d0] = MFMA32(pw[s], vf, o[d0]);
        }
}
__device__ __forceinline__ void attn_store(const f32x16 (&o)[2], float lrun, float* af, bf16_t* dst  , int lane) {
    const int r32 = lane & 31, hi = lane >> 5;
    const float lt = lrun + __shfl_xor(lrun, 32);
    if (hi == 0) af[r32] = 1.0f / lt;
#pragma unroll
    for (int r = 0; r < 16; ++r) {
        const int q = crow(r, hi); const float li = af[q];
        dst[(size_t)q * 1024 + r32] = f2bf(o[0][r] * li);
        dst[(size_t)q * 1024 + 32 + r32] = f2bf(o[1][r] * li);
    }
}

constexpr int MLA_KROW = 208, MLA_KB = 64 * MLA_KROW, MLA_VB = 8192, MLA_STAGE = MLA_KB + MLA_VB, MLA_AF = 2 * MLA_STAGE;
__device__ void mla_unit(const Params& p, char* lds, int b, int h, int qb) {
    const int tid = threadIdx.x, lane = tid & 63, wid = tid >> 6, r32 = lane & 31, hi = lane >> 5;
    const bf16_t* Q = (const bf16_t*)p.out;
    const bf16_t* Kg = (const bf16_t*)((const char*)p.out + 24 * MiB) + (size_t)b * S * 768 + h * 96;
    const bf16_t* Vg = (const bf16_t*)(p.ws + OFF_RS + S_V) + (size_t)b * S * 512 + h * 64;
    float* af = (float*)(lds + MLA_AF) + wid * 32;
    bf16x8 qf[6];
    {
        const bf16_t* qp = Q + (size_t)(b * S + qb * 256 + wid * 32 + r32) * 768 + h * 96 + hi * 8;
#pragma unroll
        for (int ks = 0; ks < 6; ++ks) qf[ks] = *(const bf16x8*)(qp + ks * 16);
    }
    const int k_id1 = tid + 512;
    const int kr0 = tid / 12, kc0 = tid - kr0 * 12, kr1 = k_id1 / 12, kc1 = k_id1 - kr1 * 12;
    const bool k2 = k_id1 < 768;
    const int vr = tid >> 3, vc = tid & 7;
    const int kst0 = kr0 * MLA_KROW + kc0 * 16, kst1 = kr1 * MLA_KROW + kc1 * 16, vst = MLA_KB + (vc >> 2) * 4096 + vr * 64 + (vc & 3) * 16;
    const bf16_t* kp0 = Kg + (size_t)kr0 * 768 + kc0 * 8;
    const bf16_t* kp1 = Kg + (size_t)kr1 * 768 + kc1 * 8;
    const bf16_t* vp = Vg + (size_t)vr * 512 + vc * 8;
    u32x4 rk0, rk1, rv;
    rk0 = *(const u32x4*)kp0; if (k2) rk1 = *(const u32x4*)kp1; rv = *(const u32x4*)vp;
    *(u32x4*)(lds + kst0) = rk0; if (k2) *(u32x4*)(lds + kst1) = rk1; *(u32x4*)(lds + vst) = rv;
    __syncthreads();
    float mrun = -1e30f, lrun = 0.f;
    f32x16 o[2]; o[0] = (f32x16){}; o[1] = (f32x16){};
    constexpr int NT = S / 64;
    for (int t = 0; t < NT; ++t) {
        const char* cur = lds + (t & 1) * MLA_STAGE; char* nxt = lds + ((t + 1) & 1) * MLA_STAGE;
        const bool more = t + 1 < NT;
        if (more) { const size_t go = (size_t)(t + 1) * 64; rk0 = *(const u32x4*)(kp0 + go * 768); if (k2) rk1 = *(const u32x4*)(kp1 + go * 768); rv = *(const u32x4*)(vp + go * 512); }
        f32x16 s0 = (f32x16){}, s1 = (f32x16){};
#pragma unroll
        for (int ks = 0; ks < 6; ++ks) {
            const bf16x8 k0 = *(const bf16x8*)(cur + r32 * MLA_KROW + (ks * 2 + hi) * 16);
            const bf16x8 k1 = *(const bf16x8*)(cur + (32 + r32) * MLA_KROW + (ks * 2 + hi) * 16);
            s0 = MFMA32(k0, qf[ks], s0); s1 = MFMA32(k1, qf[ks], s1);
        }
        softmax_pv(s0, s1, mrun, lrun, o, cur + MLA_KB, 4096, af, lane);
        if (more) { *(u32x4*)(nxt + kst0) = rk0; if (k2) *(u32x4*)(nxt + kst1) = rk1; *(u32x4*)(nxt + vst) = rv; }
        __syncthreads();
    }
    bf16_t* dst = (bf16_t*)(p.ws + OFF_RS + S_CAT) + (size_t)(b * S + qb * 256 + wid * 32) * 1024 + h * 64;
    attn_store(o, lrun, af, dst, lane);
}

constexpr int SWA_KROW = 144, SWA_KB = 384 * SWA_KROW, SWA_VB = 2 * 384 * 64, SWA_BIAS = SWA_KB + SWA_VB, SWA_AF = SWA_BIAS + 4 * 260 * 4;
__device__ void swa_unit(const Params& p, char* lds, int b, int nblk, int g) {
    const int tid = threadIdx.x, lane = tid & 63, wid = tid >> 6, r32 = lane & 31, hi = lane >> 5;
    const bf16_t* qb = (const bf16_t*)(p.ws + OFF_RS + S_QB);
    const bf16_t* kb = (const bf16_t*)(p.ws + OFF_RS + S_KB);
    const bf16_t* vb = (const bf16_t*)(p.ws + OFF_RS + S_VB);
    float* af = (float*)(lds + SWA_AF) + wid * 32;
    float* bl = (float*)(lds + SWA_BIAS);
    for (int id = tid; id < 384 * 8; id += NTHR) {
        const int row = id >> 3, c = id & 7, pos = nblk * 128 - 128 + row;
        u32x4 kv = (u32x4){0u, 0u, 0u, 0u}, vv = kv;
        if (pos >= 0 && pos < S) { kv = *(const u32x4*)(kb + (size_t)(b * S + pos) * 128 + g * 64 + c * 8); vv = *(const u32x4*)(vb + (size_t)(b * S + pos) * 128 + g * 64 + c * 8); }
        *(u32x4*)(lds + row * SWA_KROW + c * 16) = kv;
        *(u32x4*)(lds + SWA_KB + (c >> 2) * (384 * 64) + row * 64 + (c & 3) * 16) = vv;
    }
    {
        const float* bt = (const float*)(p.ws + OFF_MISC + M_BIAS);
        for (int id = tid; id < 4 * 257; id += NTHR) { const int hl = id / 257, j = id - hl * 257; bl[hl * 260 + j] = bt[(g * 4 + hl) * 257 + j]; }
    }
    __syncthreads();
    const int hl = wid >> 1, hh = g * 4 + hl;
    const float sinkv = p.l0_sinks[hh] * LOG2E;
    for (int sb = 0; sb < 2; ++sb) {
        const int qoff = (wid & 1) * 64 + sb * 32;
        const int qrow = b * S + nblk * 128 + qoff;
        bf16x8 qf[4];
        {
            const bf16_t* qp = qb + (size_t)(qrow + r32) * 512 + hh * 64 + hi * 8;
#pragma unroll
            for (int ks = 0; ks < 4; ++ks) qf[ks] = *(const bf16x8*)(qp + ks * 16);
        }
        float mrun = sinkv, lrun = hi == 0 ? 1.0f : 0.0f;
        f32x16 o[2]; o[0] = (f32x16){}; o[1] = (f32x16){};
        const int qi = qoff + r32;
        for (int kt = 0; kt < 6; ++kt) {
            const int k0 = kt * 64;
            if (k0 - 128 - (qoff + 31) > 128 || k0 + 63 - 128 - qoff < -128) continue;
            f32x16 s0 = (f32x16){}, s1 = (f32x16){};
#pragma unroll
            for (int ks = 0; ks < 4; ++ks) {
                const bf16x8 ka = *(const bf16x8*)(lds + (k0 + r32) * SWA_KROW + (ks * 2 + hi) * 16);
                const bf16x8 kb2 = *(const bf16x8*)(lds + (k0 + 32 + r32) * SWA_KROW + (ks * 2 + hi) * 16);
                s0 = MFMA32(ka, qf[ks], s0); s1 = MFMA32(kb2, qf[ks], s1);
            }
#pragma unroll
            for (int r = 0; r < 16; ++r) {
                const int kk0 = k0 + crow(r, hi), kk1 = kk0 + 32;
                const int rel0 = kk0 - 128 - qi, rel1 = kk1 - 128 - qi;
                const int pos0 = nblk * 128 - 128 + kk0, pos1 = pos0 + 32;
                const bool v0 = rel0 >= -128 && rel0 <= 128 && pos0 >= 0 && pos0 < S;
                const bool v1 = rel1 >= -128 && rel1 <= 128 && pos1 >= 0 && pos1 < S;
                const int i0 = v0 ? rel0 + 128 : 0, i1 = v1 ? rel1 + 128 : 0;
                s0[r] = v0 ? s0[r] + bl[hl * 260 + i0] : -INFINITY;
                s1[r] = v1 ? s1[r] + bl[hl * 260 + i1] : -INFINITY;
            }
            softmax_pv(s0, s1, mrun, lrun, o, lds + SWA_KB + k0 * 64, 384 * 64, af, lane);
        }
        bf16_t* dst = (bf16_t*)(p.ws + OFF_RS + S_CAT) + (size_t)qrow * 1024 + 512 + hh * 64;
        attn_store(o, lrun, af, dst, lane);
    }
    __syncthreads();
}
__device__ void phase_attn(const Params& p, char* lds) {
    for (int u = blockIdx.x; u < 512 + 256; u += gridDim.x) {
        if (u < 512) { const int qb = u & 31, h = (u >> 5) & 7, b = u >> 8; mla_unit(p, lds, b, h, qb); }
        else { const int v = u - 512; const int g = v & 1, nblk = (v >> 1) & 63, b = v >> 7; swa_unit(p, lds, b, nblk, g); }
    }
}

struct EpiRes {
    const float* res; float* dst; int m0, n0;
    __device__ __forceinline__ void operator()(f32x4 (&acc)[4][4], int wm, int wn, int fr, int fq) const {
#pragma unroll
        for (int m = 0; m < 4; ++m) {
            const size_t off = (size_t)(m0 + wm * 64 + m * 16 + fr) * 1024 + n0 + wn * 64 + fq * 4;
#pragma unroll
            for (int n = 0; n < 4; ++n) { const f32x4 r = *(const f32x4*)(res + off + n * 16); *(f32x4*)(dst + off + n * 16) = r * ALPHA + acc[m][n]; }
        }
    }
};
__device__ void phase_outproj(const Params& p, char* lds, const bf16_t* A, const bf16_t* Wt, const float* res, float* dst) {
    for (int ti = blockIdx.x; ti < 64 * 8; ti += gridDim.x) {
        const int mt = ti >> 3, nt = ti & 7;
        EpiRes e{res, dst, mt * 256, nt * 128};
        gemm_tile(lds, plain_rows(A, 1024, mt * 256), Wt + (size_t)nt * 128 * 1024, 1024, 1024, e);
    }
}

__device__ void phase_ln_router(const Params& p, char* lds, const float* src, float* hf, bf16_t* hb, const float* g, const float* bta, int layer) {
    const int tid = threadIdx.x, lane = tid & 63, wid = tid >> 6;
    float* rwT = (float*)lds;
    int* lcnt = (int*)(lds + 65536);
    int* lbase = lcnt + 16;
    int* sel = lbase + 16;
    float* selw = (float*)(sel + 128);
    for (int i = tid; i < 16 * 1024; i += NTHR) { const int c = i >> 4, e = i & 15; rwT[e * 1024 + c] = p.router_w[i]; }
    if (tid < 16) lcnt[tid] = 0;
    __syncthreads();
    int* cnt = (int*)(p.ws + OFF_MISC + M_CNT) + layer * 16;
    int* list = (int*)(p.ws + OFF_MISC + M_LIST);
    float* gatew = (float*)(p.ws + OFF_MISC + M_GATEW);
    for (int chunk = blockIdx.x; chunk < T / 64; chunk += gridDim.x) {
        for (int j = 0; j < 8; ++j) {
            const int tl = wid * 8 + j, tok = chunk * 64 + tl;
            f32x4 v[4];
#pragma unroll
            for (int i = 0; i < 4; ++i) v[i] = *(const f32x4*)(src + (size_t)tok * 1024 + (i * 64 + lane) * 4);
            float s = 0.f;
#pragma unroll
            for (int i = 0; i < 4; ++i) s += (v[i][0] + v[i][1]) + (v[i][2] + v[i][3]);
            const float mu = wave_sum(s) * (1.0f / 1024.0f);
            float q = 0.f;
#pragma unroll
            for (int i = 0; i < 4; ++i) { v[i] = v[i] - mu; q += (v[i][0] * v[i][0] + v[i][1] * v[i][1]) + (v[i][2] * v[i][2] + v[i][3] * v[i][3]); }
            const float rstd = rsqrtf(wave_sum(q) * (1.0f / 1024.0f) + LN_EPS);
#pragma unroll
            for (int i = 0; i < 4; ++i) {
                const int c = (i * 64 + lane) * 4;
                v[i] = v[i] * rstd * *(const f32x4*)(g + c) + *(const f32x4*)(bta + c);
                *(f32x4*)(hf + (size_t)tok * 1024 + c) = v[i];
                *(u32x2*)(hb + (size_t)tok * 1024 + c) = pk4(v[i]);
            }
            float lg[16];
#pragma unroll
            for (int e = 0; e < 16; ++e) {
                float a = 0.f;
#pragma unroll
                for (int i = 0; i < 4; ++i) { const f32x4 w = *(const f32x4*)(rwT + e * 1024 + (i * 64 + lane) * 4); a += (v[i][0] * w[0] + v[i][1] * w[1]) + (v[i][2] * w[2] + v[i][3] * w[3]); }
                lg[e] = wave_sum(a);
            }
            float sc[16], bs[16];
#pragma unroll
            for (int e = 0; e < 16; ++e) { sc[e] = sigmoidf_(lg[e]); bs[e] = sc[e] + p.router_bias[e]; }
            int gsel = 0; float gbest = -INFINITY;
#pragma unroll
            for (int gq = 0; gq < 4; ++gq) {
                float m1 = -INFINITY, m2 = -INFINITY;
#pragma unroll
                for (int e = 0; e < 4; ++e) { const float x = bs[gq * 4 + e]; if (x > m1) { m2 = m1; m1 = x; } else if (x > m2) m2 = x; }
                const float gs = m1 + m2;
                if (gs > gbest) { gbest = gs; gsel = gq; }
            }
            float b0 = -INFINITY, b1 = -INFINITY, w0 = 0.f, w1 = 0.f; int e0 = 0, e1 = 0;
#pragma unroll
            for (int e = 0; e < 16; ++e) {
                if ((e >> 2) == gsel) {
                    const float x = bs[e];
                    if (x > b0) { b1 = b0; e1 = e0; w1 = w0; b0 = x; e0 = e; w0 = sc[e]; }
                    else if (x > b1) { b1 = x; e1 = e; w1 = sc[e]; }
                }
            }
            const float inv = 1.0f / (w0 + w1);
            if (lane == 0) {
                const int l0 = atomicAdd(&lcnt[e0], 1), l1 = atomicAdd(&lcnt[e1], 1);
                sel[tl * 2] = e0 | (l0 << 8); sel[tl * 2 + 1] = e1 | (l1 << 8);
                selw[tl * 2] = w0 * inv; selw[tl * 2 + 1] = w1 * inv;
            }
        }
        __syncthreads();
        if (tid < 16) lbase[tid] = atomicAdd(&cnt[tid], lcnt[tid]);
        __syncthreads();
        if (tid < 128) {
            const int sv = sel[tid], e = sv & 255, lp = sv >> 8, tk = (chunk * 64 + (tid >> 1)) * 2 + (tid & 1);
            list[e * T + lbase[e] + lp] = tk;
            gatew[tk] = selw[tid];
        }
        __syncthreads();
        if (tid < 16) lcnt[tid] = 0;
        __syncthreads();
    }
}

struct MoeTile { int e, row0, valid; };
__device__ __forceinline__ bool moe_tile(const int* cnt, int mtile, MoeTile& mt) {
    int pre = 0;
#pragma unroll 1
    for (int e = 0; e < 16; ++e) {
        const int c = cnt[e], n = (c + 255) >> 8;
        if (mtile < pre + n) { mt.e = e; mt.row0 = (mtile - pre) * 256; mt.valid = min(256, c - mt.row0); return true; }
        pre += n;
    }
    return false;
}
struct EpiMoeUp {
    bf16_t* H; const int* lst; int valid, nt;
    __device__ __forceinline__ void operator()(f32x4 (&acc)[4][4], int wm, int wn, int fr, int fq) const {
#pragma unroll
        for (int m = 0; m < 4; ++m) {
            const int r = wm * 64 + m * 16 + fr;
            if (r < valid) {
                const int tk = lst[r];
                bf16_t* dst = H + (size_t)tk * 512 + nt * 64 + wn * 32 + fq * 4;
#pragma unroll
                for (int pr = 0; pr < 2; ++pr) {
                    f32x4 o;
#pragma unroll
                    for (int k = 0; k < 4; ++k) { const float a = acc[m][2 * pr][k], b = acc[m][2 * pr + 1][k]; o[k] = a * sigmoidf_(a) * b; }
                    *(u32x2*)(dst + pr * 16) = pk4(o);
                }
            }
        }
    }
};
struct EpiMoeDn {
    bf16_t* Y; const int* lst; const float* gw; int valid, nt;
    __device__ __forceinline__ void operator()(f32x4 (&acc)[4][4], int wm, int wn, int fr, int fq) const {
#pragma unroll
        for (int m = 0; m < 4; ++m) {
            const int r = wm * 64 + m * 16 + fr;
            if (r < valid) {
                const int tk = lst[r]; const float gt = gw[tk];
                bf16_t* dst = Y + (size_t)tk * 1024 + nt * 128 + wn * 64 + fq * 4;
#pragma unroll
                for (int n = 0; n < 4; ++n) *(u32x2*)(dst + n * 16) = pk4(acc[m][n] * gt);
            }
        }
    }
};
__device__ void phase_moe_up(const Params& p, char* lds, int layer) {
    const int* cnt = (const int*)(p.ws + OFF_MISC + M_CNT) + layer * 16;
    const int* list = (const int*)(p.ws + OFF_MISC + M_LIST);
    const bf16_t* hb = (const bf16_t*)(p.ws + OFF_RA);
    const bf16_t* wup = (const bf16_t*)(p.ws + OFF_WMOE + W_UP);
    bf16_t* H = (bf16_t*)(p.ws + OFF_RS + S_HMOE);
    for (int ti = blockIdx.x;; ti += gridDim.x) {
        MoeTile mt; if (!moe_tile(cnt, ti >> 3, mt)) break;
        const int nt = ti & 7;
        const int* lst = list + mt.e * T + mt.row0;
        ARows ar; const int srow = threadIdx.x >> 3;
#pragma unroll
        for (int i = 0; i < 4; ++i) { const int r = min(srow + 64 * i, mt.valid - 1); ar.p[i] = hb + (size_t)(lst[r] >> 1) * 1024; }
        EpiMoeUp e{H, lst, mt.valid, nt};
        gemm_tile(lds, ar, wup + ((size_t)mt.e * 1024 + nt * 128) * 1024, 1024, 1024, e);
    }
}
__device__ void phase_moe_dn(const Params& p, char* lds, int layer) {
    const int* cnt = (const int*)(p.ws + OFF_MISC + M_CNT) + layer * 16;
    const int* list = (const int*)(p.ws + OFF_MISC + M_LIST);
    const bf16_t* H = (const bf16_t*)(p.ws + OFF_RS + S_HMOE);
    const bf16_t* wdn = (const bf16_t*)(p.ws + OFF_WMOE + W_DN);
    bf16_t* Y = (bf16_t*)(p.ws + OFF_RS + S_Y);
    const float* gw = (const float*)(p.ws + OFF_MISC + M_GATEW);
    for (int ti = blockIdx.x;; ti += gridDim.x) {
        MoeTile mt; if (!moe_tile(cnt, ti >> 3, mt)) break;
        const int nt = ti & 7;
        const int* lst = list + mt.e * T + mt.row0;
        ARows ar; const int srow = threadIdx.x >> 3;
#pragma unroll
        for (int i = 0; i < 4; ++i) { const int r = min(srow + 64 * i, mt.valid - 1); ar.p[i] = H + (size_t)lst[r] * 512; }
        EpiMoeDn e{Y, lst, gw, mt.valid, nt};
        gemm_tile(lds, ar, wdn + ((size_t)mt.e * 1024 + nt * 128) * 512, 512, 512, e);
    }
}
__device__ void phase_ln2(const Params& p, const float* hf, float* dstf, bf16_t* dstb, const float* g, const float* bta) {
    const int lane = threadIdx.x & 63, wid = threadIdx.x >> 6;
    const bf16_t* Y = (const bf16_t*)(p.ws + OFF_RS + S_Y);
    for (int tok = blockIdx.x * 8 + wid; tok < T; tok += gridDim.x * 8) {
        f32x4 v[4];
#pragma unroll
        for (int i = 0; i < 4; ++i) {
            const int c = (i * 64 + lane) * 4;
            const f32x4 h = *(const f32x4*)(hf + (size_t)tok * 1024 + c);
            const u32x2 y0 = *(const u32x2*)(Y + (size_t)(2 * tok) * 1024 + c), y1 = *(const u32x2*)(Y + (size_t)(2 * tok + 1) * 1024 + c);
            f32x4 a;
            a[0] = __uint_as_float(y0.x << 16) + __uint_as_float(y1.x << 16); a[1] = __uint_as_float(y0.x & 0xffff0000u) + __uint_as_float(y1.x & 0xffff0000u);
            a[2] = __uint_as_float(y0.y << 16) + __uint_as_float(y1.y << 16); a[3] = __uint_as_float(y0.y & 0xffff0000u) + __uint_as_float(y1.y & 0xffff0000u);
            v[i] = h * ALPHA + a;
        }
        float s = 0.f;
#pragma unroll
        for (int i = 0; i < 4; ++i) s += (v[i][0] + v[i][1]) + (v[i][2] + v[i][3]);
        const float mu = wave_sum(s) * (1.0f / 1024.0f);
        float q = 0.f;
#pragma unroll
        for (int i = 0; i < 4; ++i) { v[i] = v[i] - mu; q += (v[i][0] * v[i][0] + v[i][1] * v[i][1]) + (v[i][2] * v[i][2] + v[i][3] * v[i][3]); }
        const float rstd = rsqrtf(wave_sum(q) * (1.0f / 1024.0f) + LN_EPS);
#pragma unroll
        for (int i = 0; i < 4; ++i) {
            const int c = (i * 64 + lane) * 4;
            v[i] = v[i] * rstd * *(const f32x4*)(g + c) + *(const f32x4*)(bta + c);
            *(f32x4*)(dstf + (size_t)tok * 1024 + c) = v[i];
            if (dstb) *(u32x2*)(dstb + (size_t)tok * 1024 + c) = pk4(v[i]);
        }
    }
}

__device__ __forceinline__ float gelu_tanh(float x) {
    const float u = 0.7978845608028654f * (x + 0.044715f * x * x * x);
    const float t = 1.0f - 2.0f / (1.0f + __expf(2.0f * u));
    return 0.5f * x * (1.0f + t);
}
struct EpiIn1 {
    const Params& p; int m0, nt;
    __device__ __forceinline__ void operator()(f32x4 (&acc)[4][4], int wm, int wn, int fr, int fq) const {
        bf16_t* gg = (bf16_t*)(p.ws + OFF_RS + S_GG);
        bf16_t* xr = (bf16_t*)(p.ws + OFF_RS + S_XR);
#pragma unroll
        for (int m = 0; m < 4; ++m) {
            const int row = m0 + wm * 64 + m * 16 + fr;
            if (nt < 8) {
                bf16_t* dst = gg + (size_t)row * 1024 + nt * 128 + wn * 64 + fq * 4;
#pragma unroll
                for (int n = 0; n < 4; ++n) { f32x4 o;
#pragma unroll
                    for (int k = 0; k < 4; ++k) o[k] = gelu_tanh(acc[m][n][k]);
                    *(u32x2*)(dst + n * 16) = pk4(o); }
            } else {
                bf16_t* dst = xr + (size_t)row * 1024 + (nt - 8) * 128 + wn * 64 + fq * 4;
#pragma unroll
                for (int n = 0; n < 4; ++n) *(u32x2*)(dst + n * 16) = pk4(acc[m][n]);
            }
        }
    }
};
__device__ void phase_in1(const Params& p, char* lds) {
    const bf16_t* hb = (const bf16_t*)(p.ws + OFF_RA);
    const bf16_t* w = (const bf16_t*)(p.ws + OFF_WS + W_IN1);
    for (int ti = blockIdx.x; ti < 64 * 16; ti += gridDim.x) {
        const int mt = ti >> 4, nt = ti & 15;
        EpiIn1 e{p, mt * 256, nt};
        gemm_tile(lds, plain_rows(hb, 1024, mt * 256), w + (size_t)nt * 128 * 1024, 1024, 1024, e);
    }
}
__device__ void phase_conv(const Params& p) {
    const bf16_t* xr = (const bf16_t*)(p.ws + OFF_RS + S_XR);
    bf16_t* xc = (bf16_t*)(p.ws + OFF_RS + S_XC);
    const int gtid = blockIdx.x * NTHR + threadIdx.x, gsz = gridDim.x * NTHR;
    for (int i = gtid; i < T * 128; i += gsz) {
        const int row = i >> 7, c = (i & 127) * 8, s = row & (S - 1);
        float a[8];
#pragma unroll
        for (int j = 0; j < 8; ++j) a[j] = p.l1_conv_b[c + j];
#pragma unroll
        for (int k = 0; k < 4; ++k) {
            const int ss = s + k - 2;
            if (ss >= 0 && ss < S) {
                const u32x4 v = *(const u32x4*)(xr + (size_t)(row + k - 2) * 1024 + c);
                const float* w = p.l1_conv_w + k * 1024 + c;
                a[0] += w[0] * __uint_as_float(v.x << 16); a[1] += w[1] * __uint_as_float(v.x & 0xffff0000u);
                a[2] += w[2] * __uint_as_float(v.y << 16); a[3] += w[3] * __uint_as_float(v.y & 0xffff0000u);
                a[4] += w[4] * __uint_as_float(v.z << 16); a[5] += w[5] * __uint_as_float(v.z & 0xffff0000u);
                a[6] += w[6] * __uint_as_float(v.w << 16); a[7] += w[7] * __uint_as_float(v.w & 0xffff0000u);
            }
        }
        u32x4 w; w.x = pk2(a[0], a[1]); w.y = pk2(a[2], a[3]); w.z = pk2(a[4], a[5]); w.w = pk2(a[6], a[7]);
        *(u32x4*)(xc + (size_t)row * 1024 + c) = w;
    }
}
__device__ __forceinline__ bf16_t* gate_buf(const Params& p, int j) {
    switch (j) { case 0: return (bf16_t*)(p.ws + OFF_RS + S_XR); case 1: return (bf16_t*)(p.ws + OFF_RF); case 2: return (bf16_t*)(p.ws + OFF_RF + 32 * MiB); default: return (bf16_t*)(p.ws + OFF_WMOE); }
}
struct EpiGate {
    bf16_t* dst; const float* bias; int m0, c0;
    __device__ __forceinline__ void operator()(f32x4 (&acc)[4][4], int wm, int wn, int fr, int fq) const {
#pragma unroll
        for (int m = 0; m < 4; ++m) {
            const int row = m0 + wm * 64 + m * 16 + fr;
#pragma unroll
            for (int n = 0; n < 4; ++n) {
                const int c = c0 + wn * 64 + n * 16 + fq * 4;
                const f32x4 bv = *(const f32x4*)(bias + c); f32x4 o;
#pragma unroll
                for (int k = 0; k < 4; ++k) o[k] = sigmoidf_(acc[m][n][k] + bv[k]);
                *(u32x2*)(dst + (size_t)row * 1024 + c) = pk4(o);
            }
        }
    }
};
__device__ void phase_gates(const Params& p, char* lds) {
    const bf16_t* xc = (const bf16_t*)(p.ws + OFF_RS + S_XC);
    const bf16_t* wg = (const bf16_t*)(p.ws + OFF_WS + W_GATE);
    for (int ti = blockIdx.x; ti < 64 * 32; ti += gridDim.x) {
        const int mt = ti >> 5, blk = (ti >> 2) & 7, j = ti & 3;
        const float* bias = j == 0 ? p.l1_ba_f : (j == 1 ? p.l1_bx_f : (j == 2 ? p.l1_ba_b : p.l1_bx_b));
        EpiGate e{gate_buf(p, j), bias, mt * 256, blk * 128};
        gemm_tile(lds, plain_rows(xc + blk * 128, 1024, mt * 256), wg + ((size_t)j * 8 + blk) * 16384, 128, 128, e);
    }
}
__device__ __forceinline__ float lam_c(float lam) { return -8.0f * log1pf(expf(-lam)); }
__device__ __forceinline__ void lru_ab(float c8, float r, float ix, float& a, float& b) {
    const float la = c8 * r; a = __expf(la); b = sqrtf(fmaxf(1.0f - a * a, 0.0f)) * ix;
}
constexpr int LC = 64, NCH = S / LC;
__device__ void phase_scan1(const Params& p) {
    const bf16_t* xc = (const bf16_t*)(p.ws + OFF_RS + S_XC);
    const bf16_t *rf = gate_buf(p, 0), *xf = gate_buf(p, 1), *rb = gate_buf(p, 2), *xb = gate_buf(p, 3);
    float2* aggF = (float2*)(p.ws + OFF_RS + S_AGGF); float2* aggB = (float2*)(p.ws + OFF_RS + S_AGGB);
    for (int it = blockIdx.x; it < 2 * NCH * 2; it += gridDim.x) {
        const int hf = it & 1, c = (it >> 1) & (NCH - 1), b = it >> 8;
        const int ch = hf * 512 + threadIdx.x;
        const float cf = lam_c(p.l1_lam_f[ch]), cb = lam_c(p.l1_lam_b[ch]);
        float Af = 1.f, Bf = 0.f, Pb = 1.f, Hb = 0.f;
        const size_t base = (size_t)(b * S + c * LC) * 1024 + ch;
#pragma unroll 4
        for (int j = 0; j < LC; ++j) {
            const size_t o = base + (size_t)j * 1024;
            const float x = bf2f(xc[o]); float a, bb;
            lru_ab(cf, bf2f(rf[o]), bf2f(xf[o]) * x, a, bb); Bf = a * Bf + bb; Af *= a;
            lru_ab(cb, bf2f(rb[o]), bf2f(xb[o]) * x, a, bb); Hb += Pb * bb; Pb *= a;
        }
        aggF[(size_t)(b * NCH + c) * 1024 + ch] = make_float2(Af, Bf);
        aggB[(size_t)(b * NCH + c) * 1024 + ch] = make_float2(Pb, Hb);
    }
}
__device__ void phase_carry(const Params& p) {
    const float2* aggF = (const float2*)(p.ws + OFF_RS + S_AGGF); const float2* aggB = (const float2*)(p.ws + OFF_RS + S_AGGB);
    float* carF = (float*)(p.ws + OFF_RS + S_CARF); float* carB = (float*)(p.ws + OFF_RS + S_CARB);
    const int gid = blockIdx.x * NTHR + threadIdx.x;
    if (gid < 4096) {
        const int dir = gid >> 11, b = (gid >> 10) & 1, ch = gid & 1023;
        float h = 0.f;
        if (dir == 0) {
#pragma unroll 8
            for (int c = 0; c < NCH; ++c) { const size_t o = (size_t)(b * NCH + c) * 1024 + ch; carF[o] = h; const float2 ab = aggF[o]; h = ab.x * h + ab.y; }
        } else {
#pragma unroll 8
            for (int c = NCH - 1; c >= 0; --c) { const size_t o = (size_t)(b * NCH + c) * 1024 + ch; carB[o] = h; const float2 ab = aggB[o]; h = ab.x * h + ab.y; }
        }
    }
}
__device__ void phase_scan2(const Params& p) {
    const bf16_t* xc = (const bf16_t*)(p.ws + OFF_RS + S_XC);
    const bf16_t* gg = (const bf16_t*)(p.ws + OFF_RS + S_GG);
    const bf16_t *rf = gate_buf(p, 0), *xf = gate_buf(p, 1), *rb = gate_buf(p, 2), *xb = gate_buf(p, 3);
    const float* carF = (const float*)(p.ws + OFF_RS + S_CARF); const float* carB = (const float*)(p.ws + OFF_RS + S_CARB);
    bf16_t* yb = (bf16_t*)(p.ws + OFF_RA);
    for (int it = blockIdx.x; it < 2 * NCH * 2; it += gridDim.x) {
        const int hf = it & 1, c = (it >> 1) & (NCH - 1), b = it >> 8;
        const int ch = hf * 512 + threadIdx.x;
        const float cf = lam_c(p.l1_lam_f[ch]), cb = lam_c(p.l1_lam_b[ch]);
        const size_t base = (size_t)(b * S + c * LC) * 1024 + ch;
        float hfw[LC];
        float h = carF[(size_t)(b * NCH + c) * 1024 + ch];
#pragma unroll
        for (int j = 0; j < LC; ++j) {
            const size_t o = base + (size_t)j * 1024; float a, bb;
            lru_ab(cf, bf2f(rf[o]), bf2f(xf[o]) * bf2f(xc[o]), a, bb); h = a * h + bb; hfw[j] = h;
        }
        h = carB[(size_t)(b * NCH + c) * 1024 + ch];
#pragma unroll
        for (int j = LC - 1; j >= 0; --j) {
            const size_t o = base + (size_t)j * 1024; float a, bb;
            lru_ab(cb, bf2f(rb[o]), bf2f(xb[o]) * bf2f(xc[o]), a, bb); h = a * h + bb;
            yb[o] = f2bf((hfw[j] + h) * bf2f(gg[o]));
        }
    }
}

template <int PH> __device__ __forceinline__ void run_phase(const Params& p, char* lds) {
    bf16_t* ra = (bf16_t*)(p.ws + OFF_RA); float* rf = (float*)(p.ws + OFF_RF);
    if constexpr (PH == 0) phase_prologue(p, lds);
    else if constexpr (PH == 1) phase_in0(p, lds);
    else if constexpr (PH == 2) phase_up(p, lds);
    else if constexpr (PH == 3) phase_attn(p, lds);
    else if constexpr (PH == 4) phase_outproj(p, lds, (const bf16_t*)(p.ws + OFF_RS + S_CAT), (const bf16_t*)(p.ws + OFF_WS + W_OUT0), p.x, p.out);
    else if constexpr (PH == 5) phase_ln_router(p, lds, p.out, rf, ra, p.l0_ln1_g, p.l0_ln1_b, 0);
    else if constexpr (PH == 6) phase_moe_up(p, lds, 0);
    else if constexpr (PH == 7) phase_moe_dn(p, lds, 0);
    else if constexpr (PH == 8) phase_ln2(p, rf, p.out, ra, p.l0_ln2_g, p.l0_ln2_b);
    else if constexpr (PH == 9) phase_in1(p, lds);
    else if constexpr (PH == 10) phase_conv(p);
    else if constexpr (PH == 11) phase_gates(p, lds);
    else if constexpr (PH == 12) phase_scan1(p);
    else if constexpr (PH == 13) phase_carry(p);
    else if constexpr (PH == 14) phase_scan2(p);
    else if constexpr (PH == 15) phase_outproj(p, lds, ra, (const bf16_t*)(p.ws + OFF_WS + W_OUT1), p.out, rf);
    else if constexpr (PH == 16) {
        for (int id = blockIdx.x; id < 3 * TC_MOE; id += gridDim.x) conv_moe(p, lds, id, 1);
        __syncthreads();
        phase_ln_router(p, lds, rf, p.out, ra, p.l1_ln1_g, p.l1_ln1_b, 1);
    }
    else if constexpr (PH == 17) phase_moe_up(p, lds, 1);
    else if constexpr (PH == 18) phase_moe_dn(p, lds, 1);
    else if constexpr (PH == 19) phase_ln2(p, p.out, p.out, nullptr, p.l1_ln2_g, p.l1_ln2_b);
}
template <int PH> __global__ void __launch_bounds__(NTHR) k_phase(Params p) {
    extern __shared__ __attribute__((aligned(16))) char lds[];
    run_phase<PH>(p, lds);
}
template <int PH> void launch_phase(const Params& p, hipStream_t st) {
    static bool attr = false;
    if (!attr) { (void)hipFuncSetAttribute((const void*)k_phase<PH>, hipFuncAttributeMaxDynamicSharedMemorySize, LDS_BYTES); attr = true; }
    hipLaunchKernelGGL(k_phase<PH>, dim3(256), dim3(NTHR), LDS_BYTES, st, p);
}
template <int PH, int END> struct LaunchAll { static void go(const Params& p, hipStream_t st) { launch_phase<PH>(p, st); LaunchAll<PH + 1, END>::go(p, st); } };
template <int END> struct LaunchAll<END, END> { static void go(const Params&, hipStream_t) {} };
}

extern "C" void kernel_launch(void* const* d_in, const int* in_sizes, int n_in, void* d_out, int out_size, void* d_ws, size_t ws_size, hipStream_t stream) {
    Params p{};
    const float** f = (const float**)&p;
    for (int i = 0; i < 39; ++i) f[i] = (const float*)d_in[i];
    p.out = (float*)d_out; p.ws = (char*)d_ws;
    if (ws_size < WS_NEED) fprintf(stderr, "workspace too small: %zu < %zu\n", ws_size, (size_t)WS_NEED);
    (void)hipMemsetAsync(p.ws + OFF_MISC, 0, 8192, stream);
    LaunchAll<0, 20>::go(p, stream);
}
```

```cpp
#include <hip/hip_runtime.h>
#include <hip/hip_cooperative_groups.h>
#include <stdint.h>
#include <stdio.h>

namespace {
typedef unsigned short bf16_t;
typedef short bf16x8 __attribute__((ext_vector_type(8)));
typedef short s16x4 __attribute__((ext_vector_type(4)));
typedef float f32x4 __attribute__((ext_vector_type(4)));
typedef float f32x2 __attribute__((ext_vector_type(2)));
typedef float f32x16 __attribute__((ext_vector_type(16)));
typedef unsigned u32x2 __attribute__((ext_vector_type(2)));
typedef unsigned u32x4 __attribute__((ext_vector_type(4)));
#define LAS __attribute__((address_space(3)))

constexpr int T = 16384, S = 8192, D = 1024;
constexpr int NTHR = 512;
constexpr size_t MiB = (size_t)1 << 20;
constexpr float LOG2E = 1.4426950408889634f;
constexpr float ALPHA = 1.4142135623730951f;
constexpr float LN_EPS = 1e-5f, RMS_EPS = 1e-6f;
constexpr float QSCALE_MLA = 0.10206207261596575f * LOG2E;
constexpr float QSCALE_SWA = 0.125f * LOG2E;

constexpr size_t OFF_MISC = 0;
constexpr size_t OFF_WS   = 4 * MiB;
constexpr size_t OFF_WMOE = 17 * MiB;
constexpr size_t OFF_RA   = 65 * MiB;
constexpr size_t OFF_RF   = 97 * MiB;
constexpr size_t OFF_RS   = 161 * MiB;
constexpr size_t WS_NEED  = 279 * MiB;
constexpr size_t M_CNT   = 0;
constexpr size_t M_BAR   = 4096;
constexpr size_t M_BIAS  = 64 * 1024;
constexpr size_t M_SSQQ  = 128 * 1024;
constexpr size_t M_SSQKV = 640 * 1024;
constexpr size_t M_GATEW = 896 * 1024;
constexpr size_t M_ROPE  = 1 * MiB;
constexpr size_t M_LIST  = 2 * MiB;
constexpr size_t W_IN0  = 0;
constexpr size_t W_UQ   = 2560 * 1024;
constexpr size_t W_UKV  = W_UQ + 768 * 256 * 2;
constexpr size_t W_OUT0 = W_UKV + 1024 * 256 * 2;
constexpr size_t W_IN1  = W_OUT0 + 2 * MiB;
constexpr size_t W_GATE = W_IN1 + 4 * MiB;
constexpr size_t W_OUT1 = W_GATE + 1 * MiB;
constexpr size_t W_UP = 0;
constexpr size_t W_DN = 32 * MiB;
constexpr size_t S_QLAT = 0, S_KVLAT = 8 * MiB  , S_QB = 16 * MiB, S_KB = 32 * MiB, S_VB = 36 * MiB, S_V = 40 * MiB, S_CAT = 56 * MiB;
constexpr size_t S_HMOE = 0, S_Y = 32 * MiB;
constexpr size_t S_GG = 0, S_XR = 32 * MiB, S_XC = 64 * MiB, S_AGGF = 96 * MiB, S_AGGB = 100 * MiB, S_CARF = 104 * MiB, S_CARB = 106 * MiB;

struct Params {
    const float *x, *rel_bias, *router_w, *router_bias;
    const float *l0_w_in, *l0_q_norm, *l0_w_uq, *l0_kv_norm, *l0_w_ukv, *l0_sinks, *l0_w_out, *l0_ln1_g, *l0_ln1_b, *l0_w1, *l0_w3, *l0_w2, *l0_ln2_g, *l0_ln2_b;
    const float *l1_w_in, *l1_conv_w, *l1_conv_b, *l1_wa_f, *l1_ba_f, *l1_wx_f, *l1_bx_f, *l1_lam_f, *l1_wa_b, *l1_ba_b, *l1_wx_b, *l1_bx_b, *l1_lam_b, *l1_w_out,
                *l1_ln1_g, *l1_ln1_b, *l1_w1, *l1_w3, *l1_w2, *l1_ln2_g, *l1_ln2_b;
    float* out;
    char* ws;
};

__device__ __forceinline__ float bf2f(bf16_t v) { return __uint_as_float((unsigned)v << 16); }
__device__ __forceinline__ bf16_t f2bf(float f) { unsigned u = __float_as_uint(f); u += 0x7fffu + ((u >> 16) & 1u); return (bf16_t)(u >> 16); }
__device__ __forceinline__ unsigned pk2(float lo, float hi) { unsigned r; asm("v_cvt_pk_bf16_f32 %0, %1, %2" : "=v"(r) : "v"(lo), "v"(hi)); return r; }
__device__ __forceinline__ u32x2 pk4(f32x4 v) { u32x2 r; r.x = pk2(v[0], v[1]); r.y = pk2(v[2], v[3]); return r; }
__device__ __forceinline__ float sigmoidf_(float x) { return 1.0f / (1.0f + __expf(-x)); }
__device__ __forceinline__ float fsigmoid(float x) { return __builtin_amdgcn_rcpf(1.0f + __builtin_amdgcn_exp2f(-LOG2E * x)); }
__device__ __forceinline__ float wave_sum(float v) {
#pragma unroll
    for (int o = 32; o >= 1; o >>= 1) v += __shfl_xor(v, o);
    return v;
}
__device__ __forceinline__ int crow(int r, int hi) { return (r & 3) + 8 * (r >> 2) + 4 * hi; }
#define MFMA16(a, b, c) __builtin_amdgcn_mfma_f32_16x16x32_bf16(a, b, c, 0, 0, 0)
#define MFMA32(a, b, c) __builtin_amdgcn_mfma_f32_32x32x16_bf16(a, b, c, 0, 0, 0)
typedef _Float16 f16x8 __attribute__((ext_vector_type(8)));
#define MFMA16H(a, b, c) __builtin_amdgcn_mfma_f32_16x16x32_f16(__builtin_bit_cast(f16x8, a), __builtin_bit_cast(f16x8, b), c, 0, 0, 0)
__device__ __forceinline__ unsigned pkh(float lo, float hi) { unsigned r; asm("v_cvt_pk_f16_f32 %0, %1, %2" : "=v"(r) : "v"(lo), "v"(hi)); return r; }
__device__ __forceinline__ float mix_a(unsigned v) { float a; asm("v_fma_mix_f32 %0, -%1, 1.0, 1.0 op_sel_hi:[1,0,0]" : "=v"(a) : "v"(v)); return a; }
__device__ __forceinline__ float mix_gx(unsigned v, unsigned x) { float b; asm("v_fma_mix_f32 %0, %1, %2, 0 op_sel:[1,0,0] op_sel_hi:[1,1,0]" : "=v"(b) : "v"(v), "v"(x)); return b; }

__device__ __forceinline__ float gelu_tanh(float x) {
    const float u = 0.7978845608028654f * (x + 0.044715f * x * x * x);
    const float t = 1.0f - 2.0f * __builtin_amdgcn_rcpf(1.0f + __builtin_amdgcn_exp2f(2.0f * LOG2E * u));
    return 0.5f * x * (1.0f + t);
}
__device__ __forceinline__ int tidx() { int t = threadIdx.x; asm volatile("" : "+v"(t)); return t; }

constexpr int G_A_BYTES = 256 * 128, G_B_BYTES = 128 * 128, G_STAGE = G_A_BYTES + G_B_BYTES;
constexpr int LDS_BYTES = 131072, LDS_MTAB = LDS_BYTES + 16  , LDS_TOTAL = LDS_MTAB + 160 * 8 + 64;

struct ARows { const bf16_t* p[4]; };

template <class Epi>
__device__ __forceinline__ void gemm_tile(char* lds, const ARows& ar, const bf16_t* Bt, int ldb, int K, const Epi& epi) {
    const int tid = tidx(), lane = tid & 63, wid = tid >> 6, wm = wid >> 1, wn = wid & 1, fr = lane & 15, fq = lane >> 4;
    const int srow = tid >> 3, skc = tid & 7;
    const int st_off = srow * 128 + ((skc ^ (srow & 7)) << 4);
    const bf16_t* bp0 = Bt + (size_t)srow * ldb + skc * 8;
    const bf16_t* bp1 = Bt + (size_t)(srow + 64) * ldb + skc * 8;
    const int kofs = skc * 8;
    f32x4 acc[4][4];
#pragma unroll
    for (int m = 0; m < 4; ++m)
#pragma unroll
        for (int n = 0; n < 4; ++n) acc[m][n] = (f32x4){0.f, 0.f, 0.f, 0.f};
    u32x4 ra[4], rb[2];
    const int nk = K >> 6;
#pragma unroll
    for (int i = 0; i < 4; ++i) ra[i] = *(const u32x4*)(ar.p[i] + kofs);
    rb[0] = *(const u32x4*)bp0; rb[1] = *(const u32x4*)bp1;
#pragma unroll
    for (int i = 0; i < 4; ++i) *(u32x4*)(lds + st_off + i * 8192) = ra[i];
    *(u32x4*)(lds + G_A_BYTES + st_off) = rb[0]; *(u32x4*)(lds + G_A_BYTES + st_off + 8192) = rb[1];
    __syncthreads();
    const int fa = (wm * 64 + fr) * 128, fb = G_A_BYTES + (wn * 64 + fr) * 128;
    const int c0 = ((fq ^ (fr & 7)) << 4), c1 = (((4 + fq) ^ (fr & 7)) << 4);
#pragma unroll 1
    for (int kt = 0; kt < nk; ++kt) {
        char* cur = lds + (kt & 1) * G_STAGE;
        char* nxt = lds + ((kt + 1) & 1) * G_STAGE;
        const bool more = (kt + 1 < nk);
        if (more) {
            const int ko = (kt + 1) * 64;
#pragma unroll
            for (int i = 0; i < 4; ++i) ra[i] = *(const u32x4*)(ar.p[i] + ko + kofs);
            rb[0] = *(const u32x4*)(bp0 + ko); rb[1] = *(const u32x4*)(bp1 + ko);
        }
#pragma unroll
        for (int kk = 0; kk < 2; ++kk) {
            const int cc = kk ? c1 : c0;
            bf16x8 af[4], bfr[4];
#pragma unroll
            for (int m = 0; m < 4; ++m) af[m] = *(const bf16x8*)(cur + fa + m * 2048 + cc);
#pragma unroll
            for (int n = 0; n < 4; ++n) bfr[n] = *(const bf16x8*)(cur + fb + n * 2048 + cc);
#pragma unroll
            for (int m = 0; m < 4; ++m)
#pragma unroll
                for (int n = 0; n < 4; ++n) acc[m][n] = MFMA16(bfr[n], af[m], acc[m][n]);
        }
        if (more) {
#pragma unroll
            for (int i = 0; i < 4; ++i) *(u32x4*)(nxt + st_off + i * 8192) = ra[i];
            *(u32x4*)(nxt + G_A_BYTES + st_off) = rb[0]; *(u32x4*)(nxt + G_A_BYTES + st_off + 8192) = rb[1];
        }
        __syncthreads();
    }
    epi(acc, wm, wn, fr, fq);
}

namespace pg8 {
constexpr int BM = 256, BK = 64, HALF = 128, HTB = HALF * BK * 2, STAGE_BYTES = 8 * HTB, NXCD = 8, WGM = 8;
__device__ __forceinline__ int lds_byte(int r, int c) { const int st = (r >> 4) * 2 + (c >> 5), rr = r & 15, cc = c & 31, ob = rr * 64 + cc * 2; return st * 1024 + (ob ^ (((ob >> 9) & 1) << 5)); }
__device__ __forceinline__ void stage_rc(int b, int& R, int& C) { const int st = b / 1024, sb = b % 1024, swz = sb ^ (((sb >> 9) & 1) << 5); R = (st >> 1) * 16 + swz / 64; C = (st & 1) * 32 + (swz % 64) / 2; }
__device__ __forceinline__ int perm32(int rho) { const int n = rho >> 4, i = rho & 15; return 8 * (i >> 2) + 4 * n + (i & 3); }
struct Unit { int pm, pn, e, valid; const int* lst; };
struct StaticOrder {
    int nM, nN, nwg, G, c;
    __device__ void init(int M, int N, int G_, int c_) { nM = M / BM; nN = N / BM; nwg = nM * nN; G = G_; c = c_; }
    __device__ bool next(int i, Unit& u) const {
        const long L = (long)i * G + c; if (L >= nwg) return false;
        int wgid = (int)L; { const int q = nwg / NXCD, r = nwg % NXCD, xcd = wgid % NXCD, off = wgid / NXCD; wgid = (xcd < r ? xcd * (q + 1) : r * (q + 1) + (xcd - r) * q) + off; }
        const int nig = WGM * nN, gid = wgid / nig, fm = gid * WGM, gsz = (nM - fm) < WGM ? (nM - fm) : WGM;
        u.pm = fm + ((wgid % nig) % gsz); u.pn = (wgid % nig) / gsz; u.e = 0; u.valid = 256; u.lst = nullptr; return true;
    }
};
struct DenseRows { __device__ __forceinline__ unsigned rowoff(const Unit& u, int row, int K) const { return (unsigned)(u.pm * BM + row) * (unsigned)K * 2u; } };

#define PG8_LAS __attribute__((address_space(3)))
template <bool HOOKS = false, class Epi, class Sched, class ARowSrc>
__device__ __forceinline__ void gemm_phase(char* lds_generic, const bf16_t* Abase, const bf16_t* Btbase, int K, const Sched& S, const ARowSrc& AR, const Epi& E) {
    PG8_LAS unsigned char* lds = (PG8_LAS unsigned char*)lds_generic;
    const int tid = tidx(), wid = __builtin_amdgcn_readfirstlane(tid >> 6), lane = tid & 63, wr = wid >> 2, wc = wid & 3, fr = lane & 15, fq = lane >> 4;
    const int nt = K / BK;
    int sR[2], sC[2]; unsigned voffB[2];
#pragma unroll
    for (int i = 0; i < 2; ++i) { stage_rc(tid * 16 + i * 8192, sR[i], sC[i]); const int Rb = Epi::PERM ? ((sR[i] & ~31) + perm32(sR[i] & 31)) : sR[i]; voffB[i] = (unsigned)(Rb * K + sC[i]) * 2u; }
    const size_t kstep = (size_t)(BK * 2);
    const size_t hstep = (size_t)HALF * K * 2;
    const size_t tstep = 2 * hstep;
    const unsigned ldsw = (unsigned)wid * 1024u;
    const int aoff = lds_byte(wr * 64 + fr, fq * 8), boff = lds_byte(wc * 32 + fr, fq * 8);
#define PG8_SA(b, h) (((b) * 2 + (h)) * HTB)
#define PG8_SB(b, h) ((4 + (b) * 2 + (h)) * HTB)
#define PG8_GLDS(src, dstoff) do { __builtin_amdgcn_global_load_lds((const __attribute__((address_space(1))) unsigned*)(src), (PG8_LAS unsigned*)(lds + (dstoff)), 16, 0, 0); asm volatile("" ::: "memory"); } while (0)
#define PG8_STAGE_B(bufoff, gbase) do { _Pragma("unroll") for (int _i = 0; _i < 2; ++_i) PG8_GLDS((const char*)(gbase) + voffB[_i], (bufoff) + ldsw + _i * 8192); } while (0)
#define PG8_STAGE_A(bufoff, AO, h, kb) do { _Pragma("unroll") for (int _i = 0; _i < 2; ++_i) PG8_GLDS((const char*)Abase + (AO)[h][_i] + (kb), (bufoff) + ldsw + _i * 8192); } while (0)
#define PG8_LDA(dst, b, h) do { _Pragma("unroll") for (int m = 0; m < 4; ++m) _Pragma("unroll") for (int k = 0; k < 2; ++k) dst[m][k] = *(const PG8_LAS bf16x8*)(lds + PG8_SA(b, h) + aoff + m * 2048 + k * 1024); } while (0)
#define PG8_LDB(dst, b, h) do { _Pragma("unroll") for (int n = 0; n < 2; ++n) _Pragma("unroll") for (int k = 0; k < 2; ++k) dst[n][k] = *(const PG8_LAS bf16x8*)(lds + PG8_SB(b, h) + boff + n * 2048 + k * 1024); } while (0)
#define PG8_MMA(ai, bj, At, Bt) do { __builtin_amdgcn_s_setprio(1); _Pragma("unroll") for (int m = 0; m < 4; ++m) _Pragma("unroll") for (int n = 0; n < 2; ++n) _Pragma("unroll") for (int k = 0; k < 2; ++k) \
        acc[ai][bj][m][n] = __builtin_amdgcn_mfma_f32_16x16x32_bf16(Bt[n][k], At[m][k], acc[ai][bj][m][n], 0, 0, 0); __builtin_amdgcn_s_setprio(0); } while (0)
#define PG8_WAIT_V(n) asm volatile("s_waitcnt vmcnt(" #n ")" ::: "memory")
#define PG8_WAIT_L(n) asm volatile("s_waitcnt lgkmcnt(" #n ")" ::: "memory")
#define PG8_BAR __builtin_amdgcn_s_barrier()
#define PG8_SCHED __builtin_amdgcn_sched_barrier(0)
    Unit cur, nxt; int ui = 0;
    if (!S.next(0, cur)) return;
    if constexpr (HOOKS) S.a_ready(cur);
    f32x4 acc[2][2][4][2];
#pragma unroll
    for (int a = 0; a < 2; ++a)
#pragma unroll
        for (int b = 0; b < 2; ++b)
#pragma unroll
            for (int m = 0; m < 4; ++m)
#pragma unroll
                for (int n = 0; n < 2; ++n) acc[a][b][m][n] = (f32x4){0.f, 0.f, 0.f, 0.f};
    bf16x8 At[4][2], B0[2][2], B1[2][2];
    unsigned aoC[2][2], aoN[2][2];
#pragma unroll
    for (int h = 0; h < 2; ++h)
#pragma unroll
        for (int i = 0; i < 2; ++i) aoC[h][i] = AR.rowoff(cur, h * HALF + sR[i], K) + (unsigned)sC[i] * 2u;
    const char* cB = (const char*)Btbase + (size_t)cur.pn * tstep;
    PG8_STAGE_B(PG8_SB(0, 0), cB); PG8_STAGE_B(PG8_SB(0, 1), cB + hstep); PG8_STAGE_A(PG8_SA(0, 0), aoC, 0, 0); PG8_STAGE_A(PG8_SA(0, 1), aoC, 1, 0);
    if (wr == 1) PG8_BAR;
    PG8_WAIT_V(2); PG8_BAR;
    PG8_STAGE_B(PG8_SB(1, 0), cB + kstep); PG8_STAGE_A(PG8_SA(1, 0), aoC, 0, kstep); PG8_STAGE_B(PG8_SB(1, 1), cB + hstep + kstep);
    PG8_WAIT_V(6); PG8_BAR;
    for (;;) {
        const bool has_next = S.next(ui + 1, nxt);
#pragma unroll
        for (int h = 0; h < 2; ++h)
#pragma unroll
            for (int i = 0; i < 2; ++i) aoN[h][i] = AR.rowoff(has_next ? nxt : cur, h * HALF + sR[i], K) + (unsigned)sC[i] * 2u;
        const char* nB = has_next ? (const char*)Btbase + (size_t)nxt.pn * tstep : cB;
#pragma unroll 1
        for (int t = 0; t < nt; t += 2) {
            const bool last = (t == nt - 2);
            if constexpr (HOOKS) { if (last && has_next) S.a_ready(nxt); }
            const unsigned k1 = (unsigned)(t + 1) * (unsigned)kstep;
            const unsigned k2 = last ? 0u : (unsigned)(t + 2) * (unsigned)kstep, k3 = k2 + (unsigned)kstep;
            unsigned ao2[2][2];
#pragma unroll
            for (int h = 0; h < 2; ++h)
#pragma unroll
                for (int i = 0; i < 2; ++i) ao2[h][i] = last ? aoN[h][i] : aoC[h][i];
            const char* b2 = last ? nB : cB + (size_t)(t + 2) * kstep; const char* b3 = b2 + kstep;
            PG8_LDB(B0, 0, 0); PG8_LDB(B1, 0, 1); PG8_SCHED; PG8_LDA(At, 0, 0); PG8_STAGE_A(PG8_SA(1, 1), aoC, 1, k1);
            PG8_WAIT_V(8); PG8_WAIT_L(0); PG8_BAR; PG8_MMA(0, 0, At, B0); PG8_MMA(0, 1, At, B1); PG8_BAR; PG8_SCHED;
            PG8_LDA(At, 0, 1); PG8_STAGE_B(PG8_SB(0, 0), b2); PG8_STAGE_B(PG8_SB(0, 1), b2 + hstep); PG8_STAGE_A(PG8_SA(0, 0), ao2, 0, k2);
            PG8_WAIT_V(8); PG8_WAIT_L(0); PG8_BAR; PG8_MMA(1, 0, At, B0); PG8_MMA(1, 1, At, B1); PG8_BAR; PG8_SCHED;
            PG8_LDB(B0, 1, 0); PG8_LDB(B1, 1, 1); PG8_SCHED; PG8_LDA(At, 1, 0); PG8_STAGE_A(PG8_SA(0, 1), ao2, 1, k2);
            PG8_WAIT_V(8); PG8_WAIT_L(0); PG8_BAR; PG8_MMA(0, 0, At, B0); PG8_MMA(0, 1, At, B1); PG8_BAR; PG8_SCHED;
            PG8_LDA(At, 1, 1); PG8_STAGE_B(PG8_SB(1, 0), b3); PG8_STAGE_B(PG8_SB(1, 1), b3 + hstep); PG8_STAGE_A(PG8_SA(1, 0), ao2, 0, k3);
            PG8_WAIT_V(8); PG8_WAIT_L(0); PG8_BAR; PG8_MMA(1, 0, At, B0); PG8_MMA(1, 1, At, B1); PG8_BAR; PG8_SCHED;
        }
        if (wr == 0) PG8_BAR;
        E(acc, cur, wr, wc, fr, fq);
        if constexpr (HOOKS) S.done(cur);
        if (!has_next) break;
#pragma unroll
        for (int a = 0; a < 2; ++a)
#pragma unroll
            for (int b = 0; b < 2; ++b)
#pragma unroll
                for (int m = 0; m < 4; ++m)
#pragma unroll
                    for (int n = 0; n < 2; ++n) acc[a][b][m][n] = (f32x4){0.f, 0.f, 0.f, 0.f};
        cur = nxt; cB = nB; ++ui;
#pragma unroll
        for (int h = 0; h < 2; ++h)
#pragma unroll
            for (int i = 0; i < 2; ++i) aoC[h][i] = aoN[h][i];
        if (wr == 1) PG8_BAR;
    }
    PG8_WAIT_V(0);
    PG8_BAR;
#undef PG8_SA
#undef PG8_SB
#undef PG8_GLDS
#undef PG8_STAGE_A
#undef PG8_STAGE_B
#undef PG8_LDA
#undef PG8_LDB
#undef PG8_MMA
#undef PG8_WAIT_V
#undef PG8_WAIT_L
#undef PG8_BAR
#undef PG8_SCHED
}
}

__device__ __forceinline__ ARows plain_rows(const bf16_t* A, int lda, int m0) {
    ARows r; const int srow = tidx() >> 3;
#pragma unroll
    for (int i = 0; i < 4; ++i) r.p[i] = A + (size_t)(m0 + srow + 64 * i) * lda;
    return r;
}

__device__ __forceinline__ int nmap(int mode, int n) {
    switch (mode) {
        case 1: { if (n < 384) return n; if (n >= 416) return n - 416 + 384; const int i = (n - 384) & 15, hf = (n - 384) >> 4; return 1152 + (i >> 2) * 8 + hf * 4 + (i & 3); }
        case 2: { const int h = n / 96, d = n - h * 96; if (d < 64) return h * 64 + d; const int i = (d - 64) & 15, hf = (d - 64) >> 4; return 512 + h * 32 + (i >> 2) * 8 + hf * 4 + (i & 3); }
        case 3: return 256 * (n >> 7) + 128 * ((n >> 2) & 1) + 32 * ((n >> 5) & 3) + 8 * ((n >> 3) & 3) + (n & 3);
        case 4: return 256 * (n >> 7) + 128 * ((n >> 2) & 1) + 32 * ((n >> 5) & 3) + 8 * ((n >> 3) & 3) + 4 + (n & 3);
        default: return n;
    }
}
__device__ __forceinline__ void tconv_tile(char* lds, const float* src, int lds_src, int N, bf16_t* dst, int ldd, int k0, int n0, int mode, const float* ks) {
    float* t = (float*)lds;
    const int tid = tidx();
    {
        const int nl = (tid & 15) * 4, n = n0 + nl, nc = n < N ? n : 0;
        f32x4 v[2]; float sc[2] = {1.f, 1.f};
#pragma unroll
        for (int i = 0; i < 2; ++i) v[i] = *(const f32x4*)(src + (size_t)(k0 + (tid >> 4) + 32 * i) * lds_src + nc);
        if (ks) {
#pragma unroll
            for (int i = 0; i < 2; ++i) sc[i] = ks[k0 + (tid >> 4) + 32 * i];
        }
#pragma unroll
        for (int i = 0; i < 2; ++i) {
            const int k = (tid >> 4) + 32 * i;
            const f32x4 w = n < N ? v[i] * sc[i] : (f32x4){0.f, 0.f, 0.f, 0.f};
#pragma unroll
            for (int j = 0; j < 4; ++j) t[(nl + j) * 65 + k] = w[j];
        }
    }
    __syncthreads();
    {
        const int nl = tid >> 3, kc = (tid & 7) * 8, n = n0 + nl;
        if (n < N) {
            const float* s = t + nl * 65 + kc;
            u32x4 w;
            if (mode == 5) { w.x = pkh(s[0], s[1]); w.y = pkh(s[2], s[3]); w.z = pkh(s[4], s[5]); w.w = pkh(s[6], s[7]); }
            else { w.x = pk2(s[0], s[1]); w.y = pk2(s[2], s[3]); w.z = pk2(s[4], s[5]); w.w = pk2(s[6], s[7]); }
            *(u32x4*)(dst + (size_t)nmap(mode, n) * ldd + k0 + kc) = w;
        }
    }
    __syncthreads();
}
__device__ __forceinline__ void tconv_tile_w(char* lds, const float* src, int lds_src, bf16_t* dst, int ldd, int k0, int n0, int mode) {
    float* t = (float*)lds;
    const int tid = tidx();
    f32x4 v[8];
#pragma unroll
    for (int i = 0; i < 8; ++i) v[i] = *(const f32x4*)(src + (size_t)(k0 + (tid >> 6) + 8 * i) * lds_src + n0 + (tid & 63) * 4);
#pragma unroll
    for (int i = 0; i < 8; ++i) {
        const int k = (tid >> 6) + 8 * i, nl = (tid & 63) * 4;
#pragma unroll
        for (int j = 0; j < 4; ++j) t[(nl + j) * 65 + k] = v[i][j];
    }
    __syncthreads();
#pragma unroll
    for (int j = 0; j < 4; ++j) {
        const int nl = (tid >> 3) + 64 * j, kc = (tid & 7) * 8;
        const float* sp = t + nl * 65 + kc;
        u32x4 w; w.x = pk2(sp[0], sp[1]); w.y = pk2(sp[2], sp[3]); w.z = pk2(sp[4], sp[5]); w.w = pk2(sp[6], sp[7]);
        *(u32x4*)(dst + (size_t)nmap(mode, n0 + nl) * ldd + k0 + kc) = w;
    }
    __syncthreads();
}
__device__ __forceinline__ void tconv_job_w(char* lds, int local, const float* src, bf16_t* dst, int K, int N, int ldd, int mode, size_t sbs, size_t dbs) {
    const int nkt = K >> 6, nnt = N >> 8, per = nkt * nnt;
    const int b = local / per, r = local - b * per, kt = r / nnt, nt = r - kt * nnt;
    tconv_tile_w(lds, src + (size_t)b * sbs, N, dst + (size_t)b * dbs, ldd, kt * 64, nt * 256, mode);
}
__device__ __forceinline__ void tconv_job(char* lds, int local, const float* src, bf16_t* dst, int K, int N, int ldd, int mode, const float* ks, size_t sbs, size_t dbs) {
    const int nkt = K >> 6, nnt = (N + 63) >> 6, per = nkt * nnt;
    const int b = local / per, r = local - b * per, kt = r / nnt, nt = r - kt * nnt;
    tconv_tile(lds, src + (size_t)b * sbs, N, N, dst + (size_t)b * dbs, ldd, kt * 64, nt * 64, mode, ks);
}
constexpr int TC_IN0 = 16 * 19, TC_UQ = 4 * 12, TC_UKV = 2 * 16, TC_SQ = 256, TC_IN1 = 16 * 32, TC_GATE = 8 * 4, TC_MOE = 16 * 32  ;
constexpr int TC_SMALL = TC_IN0 + TC_UQ + TC_UKV + TC_SQ + TC_IN1 + 4 * TC_GATE + TC_SQ;

__device__ __forceinline__ void conv_small(const Params& p, char* lds, int id) {
    bf16_t* w = (bf16_t*)(p.ws + OFF_WS);
    if (id < TC_IN0) { tconv_job(lds, id, p.l0_w_in, w + W_IN0 / 2, 1024, 1184, 1024, 1, nullptr, 0, 0); return; } id -= TC_IN0;
    if (id < TC_UQ) { tconv_job(lds, id, p.l0_w_uq, w + W_UQ / 2, 256, 768, 256, 2, p.l0_q_norm, 0, 0); return; } id -= TC_UQ;
    if (id < TC_UKV) { tconv_job(lds, id, p.l0_w_ukv, w + W_UKV / 2, 128, 1024, 256, 0, p.l0_kv_norm, 0, 0); return; } id -= TC_UKV;
    if (id < TC_SQ) { tconv_job(lds, id, p.l0_w_out, w + W_OUT0 / 2, 1024, 1024, 1024, 0, nullptr, 0, 0); return; } id -= TC_SQ;
    if (id < TC_IN1) { tconv_job(lds, id, p.l1_w_in, w + W_IN1 / 2, 1024, 2048, 1024, 0, nullptr, 0, 0); return; } id -= TC_IN1;
    if (id < TC_GATE) { tconv_job(lds, id, p.l1_wa_f, w + W_GATE / 2, 128, 128, 128, 5, nullptr, 16384, 16384); return; } id -= TC_GATE;
    if (id < TC_GATE) { tconv_job(lds, id, p.l1_wx_f, w + W_GATE / 2 + 131072, 128, 128, 128, 5, nullptr, 16384, 16384); return; } id -= TC_GATE;
    if (id < TC_GATE) { tconv_job(lds, id, p.l1_wa_b, w + W_GATE / 2 + 2 * 131072, 128, 128, 128, 5, nullptr, 16384, 16384); return; } id -= TC_GATE;
    if (id < TC_GATE) { tconv_job(lds, id, p.l1_wx_b, w + W_GATE / 2 + 3 * 131072, 128, 128, 128, 5, nullptr, 16384, 16384); return; } id -= TC_GATE;
    tconv_job(lds, id, p.l1_w_out, w + W_OUT1 / 2, 1024, 1024, 1024, 0, nullptr, 0, 0);
}
__device__ __forceinline__ void conv_moe(const Params& p, char* lds, int id, int layer) {
    bf16_t* w = (bf16_t*)(p.ws + OFF_WMOE);
    const float* w1 = layer ? p.l1_w1 : p.l0_w1; const float* w3 = layer ? p.l1_w3 : p.l0_w3; const float* w2 = layer ? p.l1_w2 : p.l0_w2;
    if (id < TC_MOE) { tconv_job_w(lds, id, w1, w + W_UP / 2, 1024, 512, 1024, 3, (size_t)1024 * 512, (size_t)1024 * 1024); return; } id -= TC_MOE;
    if (id < TC_MOE) { tconv_job_w(lds, id, w3, w + W_UP / 2, 1024, 512, 1024, 4, (size_t)1024 * 512, (size_t)1024 * 1024); return; } id -= TC_MOE;
    tconv_job_w(lds, id, w2, w + W_DN / 2, 512, 1024, 512, 0, (size_t)512 * 1024, (size_t)1024 * 512);
}

__device__ __forceinline__ void phase_prologue(const Params& p, char* lds) {
    const int nb = gridDim.x, bid = blockIdx.x, tid = tidx();
    const int gtid = bid * NTHR + tid, gsz = nb * NTHR;
    {
        bf16_t* xb = (bf16_t*)(p.ws + OFF_RA);
        for (int i0 = gtid; i0 < T * D / 8; i0 += 4 * gsz) {
            f32x4 a[4], b[4];
#pragma unroll
            for (int j = 0; j < 4; ++j) { size_t i = (size_t)i0 + (size_t)j * gsz; if (i >= (size_t)(T * D / 8)) i = T * D / 8 - 1; a[j] = *(const f32x4*)(p.x + i * 8); b[j] = *(const f32x4*)(p.x + i * 8 + 4); }
#pragma unroll
            for (int j = 0; j < 4; ++j) { const size_t i = (size_t)i0 + (size_t)j * gsz;
                if (i < (size_t)(T * D / 8)) { u32x4 w; w.x = pk2(a[j][0], a[j][1]); w.y = pk2(a[j][2], a[j][3]); w.z = pk2(b[j][0], b[j][1]); w.w = pk2(b[j][2], b[j][3]); *(u32x4*)(xb + i * 8) = w; } }
        }
    }
    {
        float2* rt = (float2*)(p.ws + OFF_MISC + M_ROPE);
        for (int i = gtid; i < S * 16; i += gsz) {
            const int pos = i >> 4, j = i & 15;
            const float inv = powf(10000.0f, -(float)j / 16.0f);
            const float ang = (float)pos * inv;
            float sn, cs; sincosf(ang, &sn, &cs);
            rt[i] = make_float2(cs, sn);
        }
    }
    {
        float* bt = (float*)(p.ws + OFF_MISC + M_BIAS);
        for (int i = gtid; i < 8 * 257; i += gsz) {
            const int h = i / 257, rel = (i - h * 257) - 128, dist = rel < 0 ? -rel : rel;
            int bucket;
            if (dist < 8) bucket = dist;
            else { int far = 2 + (31 - __clz(dist * dist)); bucket = far < 15 ? far : 15; }
            if (rel > 0) bucket += 16;
            bt[i] = p.rel_bias[bucket * 8 + h] * LOG2E;
        }
    }
    {
        u32x4* z = (u32x4*)(p.ws + OFF_WS + W_IN0 + (size_t)1184 * 1024 * 2);
        for (int i = gtid; i < 96 * 1024 * 2 / 16; i += gsz) z[i] = (u32x4){0u, 0u, 0u, 0u};
        char* zk = p.ws + OFF_WS + W_UKV;
        for (int i = gtid; i < 1024 * 16; i += gsz) *(u32x4*)(zk + (size_t)(i >> 4) * 512 + 256 + (i & 15) * 16) = (u32x4){0u, 0u, 0u, 0u};
    }
    for (int id = bid; id < TC_SMALL; id += nb) conv_small(p, lds, id);
}
__device__ __forceinline__ void phase_prologue2(const Params& p, char* lds) {
    for (int id = blockIdx.x; id < 3 * TC_MOE; id += gridDim.x) conv_moe(p, lds, id, 0);
}

struct EpiIn0 {
    static constexpr bool PERM = true;
    const Params& p;
    __device__ __forceinline__ void operator()(f32x4 (&acc)[2][2][4][2], const pg8::Unit& u, int wr, int wc, int fr, int fq) const {
        char* rs = p.ws + OFF_RS;
#pragma unroll
        for (int ai = 0; ai < 2; ++ai)
#pragma unroll
            for (int m = 0; m < 4; ++m) {
                const int row = u.pm * 256 + ai * 128 + wr * 64 + m * 16 + fr;
#pragma unroll
                for (int bj = 0; bj < 2; ++bj) {
                    const int seg = 2 * u.pn + bj, cl = wc * 32 + fq * 8;
                    const f32x4 v0 = acc[ai][bj][m][0], v1 = acc[ai][bj][m][1];
                    if (seg <= 2) {
                        float ss = (v0[0] * v0[0] + v0[1] * v0[1]) + (v0[2] * v0[2] + v0[3] * v0[3]) + (v1[0] * v1[0] + v1[1] * v1[1]) + (v1[2] * v1[2] + v1[3] * v1[3]);
                        ss += __shfl_xor(ss, 16); ss += __shfl_xor(ss, 32);
                        const u32x2 lo = pk4(v0), hi2 = pk4(v1);
                        if (seg < 2) {
                            *(u32x4*)((bf16_t*)(rs + S_QLAT) + (size_t)row * 256 + seg * 128 + cl) = (u32x4){lo.x, lo.y, hi2.x, hi2.y};
                            if (fq == 0) ((float*)(p.ws + OFF_MISC + M_SSQQ))[row * 8 + seg * 4 + wc] = ss;
                        } else {
                            bf16_t* dst = (bf16_t*)(rs + S_KVLAT) + (size_t)row * 256 + cl;
                            *(u32x4*)dst = (u32x4){lo.x, lo.y, hi2.x, hi2.y};
                            *(u32x4*)(dst + 128) = (u32x4){0u, 0u, 0u, 0u};
                            if (fq == 0) ((float*)(p.ws + OFF_MISC + M_SSQKV))[row * 4 + wc] = ss;
                        }
                    } else if (seg <= 6) {
                        const u32x2 lo = pk4(v0 * QSCALE_SWA), hi2 = pk4(v1 * QSCALE_SWA);
                        *(u32x4*)((bf16_t*)(rs + S_QB) + (size_t)row * 512 + (seg - 3) * 128 + cl) = (u32x4){lo.x, lo.y, hi2.x, hi2.y};
                    } else if (seg <= 8) {
                        const u32x2 lo = pk4(v0), hi2 = pk4(v1);
                        *(u32x4*)((bf16_t*)(rs + (seg == 7 ? S_KB : S_VB)) + (size_t)row * 128 + cl) = (u32x4){lo.x, lo.y, hi2.x, hi2.y};
                    } else if (wc == 0) {
                        const int pos = row & (S - 1);
                        const float2* rt = (const float2*)(p.ws + OFF_MISC + M_ROPE) + pos * 16 + fq * 4;
                        f32x4 o1, o2;
#pragma unroll
                        for (int r = 0; r < 4; ++r) { const float2 cs = rt[r]; o1[r] = v0[r] * cs.x - v1[r] * cs.y; o2[r] = v0[r] * cs.y + v1[r] * cs.x; }
                        bf16_t* kd = (bf16_t*)((char*)p.out + 24 * MiB) + (size_t)row * 768 + 64 + fq * 4;
                        const u32x2 w1 = pk4(o1), w2 = pk4(o2);
#pragma unroll
                        for (int h = 0; h < 8; ++h) { *(u32x2*)(kd + h * 96) = w1; *(u32x2*)(kd + h * 96 + 16) = w2; }
                    }
                }
            }
    }
};
__device__ __forceinline__ void phase_in0(const Params& p, char* lds) {
    pg8::StaticOrder so; so.init(T, gridDim.x == 256 ? 1024 : 1280, gridDim.x, blockIdx.x);
    EpiIn0 e{p};
    pg8::gemm_phase(lds, (const bf16_t*)(p.ws + OFF_RA), (const bf16_t*)(p.ws + OFF_WS + W_IN0), 1024, so, pg8::DenseRows{}, e);
}
struct In0Tile4 {
    int c;
    __device__ bool next(int i, pg8::Unit& u) const { if (i > 0 || c >= 64) return false; u.pm = c; u.pn = 4; u.e = 0; u.valid = 256; u.lst = nullptr; return true; }
    __device__ __forceinline__ void a_ready(const pg8::Unit&) const {}
};

struct EpiQup {
    const Params& p; int m0, nt;
    __device__ __forceinline__ void operator()(f32x4 (&acc)[4][4], int wm, int wn, int fr, int fq) const {
        bf16_t* Q = (bf16_t*)p.out;
        const float* ssq = (const float*)(p.ws + OFF_MISC + M_SSQQ);
#pragma unroll
        for (int m = 0; m < 4; ++m) {
            const int row = m0 + wm * 64 + m * 16 + fr;
            const f32x4 s4 = *(const f32x4*)(ssq + row * 8), s5 = *(const f32x4*)(ssq + row * 8 + 4);
            const float sc = rsqrtf((((s4[0] + s4[1]) + (s4[2] + s4[3])) + ((s5[0] + s5[1]) + (s5[2] + s5[3]))) * (1.0f / 256.0f) + RMS_EPS) * QSCALE_MLA;
            if (nt < 4) {
                bf16_t* dst = Q + (size_t)row * 768 + (nt * 2 + wn) * 96 + fq * 4;
#pragma unroll
                for (int n = 0; n < 4; ++n) *(u32x2*)(dst + n * 16) = pk4(acc[m][n] * sc);
            } else {
                const int pos = row & (S - 1);
                const float2* rt = (const float2*)(p.ws + OFF_MISC + M_ROPE) + pos * 16 + fq * 4;
#pragma unroll
                for (int pr = 0; pr < 2; ++pr) {
                    const int h = (nt - 4) * 4 + wn * 2 + pr;
                    f32x4 o1, o2;
#pragma unroll
                    for (int r = 0; r < 4; ++r) { const float2 cs = rt[r]; const float x1 = acc[m][2 * pr][r] * sc, x2 = acc[m][2 * pr + 1][r] * sc; o1[r] = x1 * cs.x - x2 * cs.y; o2[r] = x1 * cs.y + x2 * cs.x; }
                    bf16_t* dst = Q + (size_t)row * 768 + h * 96 + 64 + fq * 4;
                    *(u32x2*)dst = pk4(o1); *(u32x2*)(dst + 16) = pk4(o2);
                }
            }
        }
    }
};
struct EpiKVup {
    const Params& p; int m0, nt;
    __device__ __forceinline__ void operator()(f32x4 (&acc)[4][4], int wm, int wn, int fr, int fq) const {
        bf16_t* Kb = (bf16_t*)((char*)p.out + 24 * MiB);
        bf16_t* Vb = (bf16_t*)(p.ws + OFF_RS + S_V);
        const float* ssq = (const float*)(p.ws + OFF_MISC + M_SSQKV);
#pragma unroll
        for (int m = 0; m < 4; ++m) {
            const int row = m0 + wm * 64 + m * 16 + fr;
            const f32x4 s4 = *(const f32x4*)(ssq + row * 4);
            const float sc = rsqrtf(((s4[0] + s4[1]) + (s4[2] + s4[3])) * (1.0f / 128.0f) + RMS_EPS);
            bf16_t* dst = wn == 0 ? Kb + (size_t)row * 768 + nt * 96 + fq * 4 : Vb + (size_t)row * 512 + nt * 64 + fq * 4;
#pragma unroll
            for (int n = 0; n < 4; ++n) *(u32x2*)(dst + n * 16) = pk4(acc[m][n] * sc);
        }
    }
};
__device__ __forceinline__ void phase_up_old(const Params& p, char* lds) {
    const bf16_t* qlat = (const bf16_t*)(p.ws + OFF_RS + S_QLAT);
    const bf16_t* kvlat = (const bf16_t*)(p.ws + OFF_RS + S_KVLAT);
    const bf16_t* wuq = (const bf16_t*)(p.ws + OFF_WS + W_UQ);
    const bf16_t* wukv = (const bf16_t*)(p.ws + OFF_WS + W_UKV);
    for (int ti = blockIdx.x; ti < 64 * 14; ti += gridDim.x) {
        const int mt = ti / 14, r = ti - mt * 14;
        if (r < 6) { EpiQup e{p, mt * 256, r}; gemm_tile(lds, plain_rows(qlat, 256, mt * 256), wuq + (size_t)r * 128 * 256, 256, 256, e); }
        else { EpiKVup e{p, mt * 256, r - 6}; gemm_tile(lds, plain_rows(kvlat, 256, mt * 256), wukv + (size_t)(r - 6) * 128 * 256, 256, 128, e); }
    }
}

struct EpiQup8 {
    static constexpr bool PERM = true;
    const Params& p;
    __device__ __forceinline__ void operator()(f32x4 (&acc)[2][2][4][2], const pg8::Unit& u, int wr, int wc, int fr, int fq) const {
        bf16_t* Q = (bf16_t*)p.out;
        float sc[2][4];
#pragma unroll
        for (int ai = 0; ai < 2; ++ai) {
            f32x4 s4[4], s5[4];
#pragma unroll
            for (int m = 0; m < 4; ++m) { const float* ssq = (const float*)(p.ws + OFF_MISC + M_SSQQ) + (u.pm * 256 + ai * 128 + wr * 64 + m * 16 + fr) * 8; s4[m] = *(const f32x4*)ssq; s5[m] = *(const f32x4*)(ssq + 4); }
#pragma unroll
            for (int m = 0; m < 4; ++m) sc[ai][m] = rsqrtf((((s4[m][0] + s4[m][1]) + (s4[m][2] + s4[m][3])) + ((s5[m][0] + s5[m][1]) + (s5[m][2] + s5[m][3]))) * (1.0f / 256.0f) + RMS_EPS) * QSCALE_MLA;
        }
        if (u.pn < 2) {
#pragma unroll
            for (int ai = 0; ai < 2; ++ai)
#pragma unroll
                for (int m = 0; m < 4; ++m) {
                    const int row = u.pm * 256 + ai * 128 + wr * 64 + m * 16 + fr; const float scr = sc[ai][m];
#pragma unroll
                    for (int bj = 0; bj < 2; ++bj) {
                        const u32x2 lo = pk4(acc[ai][bj][m][0] * scr), hi2 = pk4(acc[ai][bj][m][1] * scr);
                        *(u32x4*)(Q + (size_t)row * 768 + (4 * u.pn + 2 * bj + (wc >> 1)) * 96 + (wc & 1) * 32 + fq * 8) = (u32x4){lo.x, lo.y, hi2.x, hi2.y};
                    }
                }
        } else {
#pragma unroll
            for (int ai = 0; ai < 2; ++ai) {
                float2 cs[4][4];
#pragma unroll
                for (int m = 0; m < 4; ++m) {
                    const float2* rt = (const float2*)(p.ws + OFF_MISC + M_ROPE) + ((u.pm * 256 + ai * 128 + wr * 64 + m * 16 + fr) & (S - 1)) * 16 + fq * 4;
#pragma unroll
                    for (int r = 0; r < 4; ++r) cs[m][r] = rt[r];
                }
#pragma unroll
                for (int m = 0; m < 4; ++m) {
                    const int row = u.pm * 256 + ai * 128 + wr * 64 + m * 16 + fr; const float scr = sc[ai][m];
                    f32x4 cv, sv;
#pragma unroll
                    for (int r = 0; r < 4; ++r) { cv[r] = cs[m][r].x * scr; sv[r] = cs[m][r].y * scr; }
#pragma unroll
                    for (int bj = 0; bj < 2; ++bj) {
                        const f32x4 v0 = acc[ai][bj][m][0], v1 = acc[ai][bj][m][1];
                        bf16_t* dst = Q + (size_t)row * 768 + (4 * bj + wc) * 96 + 64 + fq * 4;
                        *(u32x2*)dst = pk4(v0 * cv - v1 * sv); *(u32x2*)(dst + 16) = pk4(v0 * sv + v1 * cv);
                    }
                }
            }
        }
    }
};
struct EpiKVup8 {
    static constexpr bool PERM = true;
    const Params& p;
    __device__ __forceinline__ void operator()(f32x4 (&acc)[2][2][4][2], const pg8::Unit& u, int wr, int wc, int fr, int fq) const {
        bf16_t* Kb = (bf16_t*)((char*)p.out + 24 * MiB);
        bf16_t* Vb = (bf16_t*)(p.ws + OFF_RS + S_V);
        const float* ssq = (const float*)(p.ws + OFF_MISC + M_SSQKV);
        float scs[2][4];
        {
            f32x4 s4[2][4];
#pragma unroll
            for (int ai = 0; ai < 2; ++ai)
#pragma unroll
                for (int m = 0; m < 4; ++m) s4[ai][m] = *(const f32x4*)(ssq + (u.pm * 256 + ai * 128 + wr * 64 + m * 16 + fr) * 4);
#pragma unroll
            for (int ai = 0; ai < 2; ++ai)
#pragma unroll
                for (int m = 0; m < 4; ++m) scs[ai][m] = rsqrtf(((s4[ai][m][0] + s4[ai][m][1]) + (s4[ai][m][2] + s4[ai][m][3])) * (1.0f / 128.0f) + RMS_EPS);
        }
#pragma unroll
        for (int ai = 0; ai < 2; ++ai)
#pragma unroll
            for (int m = 0; m < 4; ++m) {
                const int row = u.pm * 256 + ai * 128 + wr * 64 + m * 16 + fr;
                const float sc = scs[ai][m];
#pragma unroll
                for (int bj = 0; bj < 2; ++bj) {
                    const int h = 2 * u.pn + bj;
                    bf16_t* dst = wc < 2 ? Kb + (size_t)row * 768 + h * 96 + wc * 32 + fq * 8 : Vb + (size_t)row * 512 + h * 64 + (wc - 2) * 32 + fq * 8;
                    const u32x2 lo = pk4(acc[ai][bj][m][0] * sc), hi2 = pk4(acc[ai][bj][m][1] * sc);
                    *(u32x4*)dst = (u32x4){lo.x, lo.y, hi2.x, hi2.y};
                }
            }
    }
};
__device__ __forceinline__ void phase_up(const Params& p, char* lds) {
    if (gridDim.x == 256) {
        if (blockIdx.x < 64) {
            In0Tile4 so{(int)blockIdx.x}; EpiIn0 e{p};
            pg8::gemm_phase(lds, (const bf16_t*)(p.ws + OFF_RA), (const bf16_t*)(p.ws + OFF_WS + W_IN0), 1024, so, pg8::DenseRows{}, e);
        } else {
            { pg8::StaticOrder so; so.init(T, 768, 192, blockIdx.x - 64); EpiQup8 e{p};
              pg8::gemm_phase(lds, (const bf16_t*)(p.ws + OFF_RS + S_QLAT), (const bf16_t*)(p.ws + OFF_WS + W_UQ), 256, so, pg8::DenseRows{}, e); }
            { pg8::StaticOrder so; so.init(T, 1024, 192, blockIdx.x - 64); EpiKVup8 e{p};
              pg8::gemm_phase(lds, (const bf16_t*)(p.ws + OFF_RS + S_KVLAT), (const bf16_t*)(p.ws + OFF_WS + W_UKV), 256, so, pg8::DenseRows{}, e); }
        }
    } else {
        { pg8::StaticOrder so; so.init(T, 768, gridDim.x, blockIdx.x); EpiQup8 e{p};
          pg8::gemm_phase(lds, (const bf16_t*)(p.ws + OFF_RS + S_QLAT), (const bf16_t*)(p.ws + OFF_WS + W_UQ), 256, so, pg8::DenseRows{}, e); }
        { pg8::StaticOrder so; so.init(T, 1024, gridDim.x, blockIdx.x); EpiKVup8 e{p};
          pg8::gemm_phase(lds, (const bf16_t*)(p.ws + OFF_RS + S_KVLAT), (const bf16_t*)(p.ws + OFF_WS + W_UKV), 256, so, pg8::DenseRows{}, e); }
    }
}

__device__ __forceinline__ s16x4 vtr(const char* pl) {
    typedef short v4i16_t __attribute__((ext_vector_type(4)));
    return __builtin_bit_cast(s16x4, __builtin_amdgcn_ds_read_tr16_b64_v4i16((LAS v4i16_t*)(LAS char*)pl));
}
constexpr float ATT_THR = 8.0f;
constexpr bool MLA_V2 = true;
#define MX3(a, b, c) __builtin_fmaxf(__builtin_fmaxf((a), (b)), (c))
__device__ __forceinline__ void softmax_pv(f32x16& s0, f32x16& s1, float& mrun, float& lrun, f32x16 (&o)[2], f32x16& cinit, bool first, const char* vt, int dstride, float* af, int lane) {
    const int r32 = lane & 31, hi = lane >> 5;
    float ma = MX3(s0[0], s0[1], s1[0]), mb = MX3(s0[2], s0[3], s1[1]); ma = MX3(ma, s1[2], s1[3]);
#pragma unroll
    for (int r = 4; r < 16; r += 4) { ma = MX3(ma, s0[r], s0[r + 1]); mb = MX3(mb, s0[r + 2], s0[r + 3]); ma = MX3(ma, s1[r], s1[r + 1]); mb = MX3(mb, s1[r + 2], s1[r + 3]); }
    float mx = __builtin_fmaxf(ma, mb);
    mx = __builtin_fmaxf(mx, __shfl_xor(mx, 32));
    if (__any(first || mx > ATT_THR)) {
        const float delta = first ? mx : __builtin_fmaxf(mx, 0.0f);
        mrun += delta;
#pragma unroll
        for (int r = 0; r < 16; ++r) { s0[r] -= delta; s1[r] -= delta; cinit[r] = -mrun; }
        if (!first) {
            const float alpha = __builtin_amdgcn_exp2f(-delta);
            lrun *= alpha;
            if (hi == 0) af[r32] = alpha;
#pragma unroll
            for (int r = 0; r < 16; ++r) { const float a = af[crow(r, hi)]; o[0][r] *= a; o[1][r] *= a; }
        }
    }
    float ls = 0.f;
#pragma unroll
    for (int r = 0; r < 16; ++r) { s0[r] = __builtin_amdgcn_exp2f(s0[r]); s1[r] = __builtin_amdgcn_exp2f(s1[r]); ls += s0[r] + s1[r]; }
    lrun += ls;
    bf16x8 pw[4];
#pragma unroll
    for (int s = 0; s < 4; ++s) {
        u32x4 w;
        if (s < 2) { w.x = pk2(s0[8 * s], s0[8 * s + 1]); w.y = pk2(s0[8 * s + 2], s0[8 * s + 3]); w.z = pk2(s0[8 * s + 4], s0[8 * s + 5]); w.w = pk2(s0[8 * s + 6], s0[8 * s + 7]); }
        else { const int q = s - 2; w.x = pk2(s1[8 * q], s1[8 * q + 1]); w.y = pk2(s1[8 * q + 2], s1[8 * q + 3]); w.z = pk2(s1[8 * q + 4], s1[8 * q + 5]); w.w = pk2(s1[8 * q + 6], s1[8 * q + 7]); }
        pw[s] = __builtin_bit_cast(bf16x8, w);
    }
    const char* vp = vt + ((lane >> 4) & 1) * 32 + (lane & 3) * 8 + (4 * hi + ((lane & 15) >> 2)) * 64;
#pragma unroll
    for (int d0 = 0; d0 < 2; ++d0)
#pragma unroll
        for (int s = 0; s < 4; ++s) {
            const s16x4 lo = vtr(vp + d0 * dstride + s * 1024), hh = vtr(vp + d0 * dstride + s * 1024 + 512);
            const bf16x8 vf = (bf16x8){lo[0], lo[1], lo[2], lo[3], hh[0], hh[1], hh[2], hh[3]};
            o[d0] = MFMA32(pw[s], vf, o[d0]);
        }
}
__device__ __forceinline__ void attn_store(const f32x16 (&o)[2], float lrun, float* af, bf16_t* dst  , int lane) {
    const int r32 = lane & 31, hi = lane >> 5;
    const float lt = lrun + __shfl_xor(lrun, 32);
    if (hi == 0) af[r32] = 1.0f / lt;
#pragma unroll
    for (int r = 0; r < 16; ++r) {
        const int q = crow(r, hi); const float li = af[q];
        dst[(size_t)q * 1024 + r32] = f2bf(o[0][r] * li);
        dst[(size_t)q * 1024 + 32 + r32] = f2bf(o[1][r] * li);
    }
}

constexpr int MLA_KROW = 208, MLA_KB = 64 * MLA_KROW, MLA_VB = 8192, MLA_STAGE = MLA_KB + MLA_VB, MLA_AF = 2 * MLA_STAGE;
__device__ __forceinline__ void mla_unit(const Params& p, char* lds, int b, int h, int qb) {
    const int tid = tidx(), lane = tid & 63, wid = tid >> 6, r32 = lane & 31, hi = lane >> 5;
    const bf16_t* Q = (const bf16_t*)p.out;
    const bf16_t* Kg = (const bf16_t*)((const char*)p.out + 24 * MiB) + (size_t)b * S * 768 + h * 96;
    const bf16_t* Vg = (const bf16_t*)(p.ws + OFF_RS + S_V) + (size_t)b * S * 512 + h * 64;
    float* af = (float*)(lds + MLA_AF) + wid * 32;
    bf16x8 qf[6];
    {
        const bf16_t* qp = Q + (size_t)(b * S + qb * 256 + wid * 32 + r32) * 768 + h * 96 + hi * 8;
#pragma unroll
        for (int ks = 0; ks < 6; ++ks) qf[ks] = *(const bf16x8*)(qp + ks * 16);
    }
    const int k_id1 = tid + 512;
    const int kr0 = tid / 12, kc0 = tid - kr0 * 12, kr1 = k_id1 / 12, kc1 = k_id1 - kr1 * 12;
    const bool k2 = k_id1 < 768;
    const int vr = tid >> 3, vc = tid & 7;
    const int kst0 = kr0 * MLA_KROW + kc0 * 16, kst1 = kr1 * MLA_KROW + kc1 * 16, vst = MLA_KB + (vc >> 2) * 4096 + vr * 64 + (vc & 3) * 16;
    const bf16_t* kp0 = Kg + (size_t)kr0 * 768 + kc0 * 8;
    const bf16_t* kp1 = Kg + (size_t)kr1 * 768 + kc1 * 8;
    const bf16_t* vp = Vg + (size_t)vr * 512 + vc * 8;
    u32x4 rk0, rk1, rv;
    rk0 = *(const u32x4*)kp0; if (k2) rk1 = *(const u32x4*)kp1; rv = *(const u32x4*)vp;
    *(u32x4*)(lds + kst0) = rk0; if (k2) *(u32x4*)(lds + kst1) = rk1; *(u32x4*)(lds + vst) = rv;
    __syncthreads();
    float mrun = 0.f, lrun = 0.f;
    f32x16 cinit = (f32x16){};
    f32x16 o[2]; o[0] = (f32x16){}; o[1] = (f32x16){};
    constexpr int NT = S / 64;
    for (int t = 0; t < NT; ++t) {
        const char* cur = lds + (t & 1) * MLA_STAGE; char* nxt = lds + ((t + 1) & 1) * MLA_STAGE;
        const bool more = t + 1 < NT;
        if (more) { const size_t go = (size_t)(t + 1) * 64; rk0 = *(const u32x4*)(kp0 + go * 768); if (k2) rk1 = *(const u32x4*)(kp1 + go * 768); rv = *(const u32x4*)(vp + go * 512); }
        f32x16 s0 = cinit, s1 = cinit;
#pragma unroll
        for (int ks = 0; ks < 6; ++ks) {
            const bf16x8 k0 = *(const bf16x8*)(cur + r32 * MLA_KROW + (ks * 2 + hi) * 16);
            const bf16x8 k1 = *(const bf16x8*)(cur + (32 + r32) * MLA_KROW + (ks * 2 + hi) * 16);
            s0 = MFMA32(k0, qf[ks], s0); s1 = MFMA32(k1, qf[ks], s1);
        }
        softmax_pv(s0, s1, mrun, lrun, o, cinit, t == 0, cur + MLA_KB, 4096, af, lane);
        if (more) { *(u32x4*)(nxt + kst0) = rk0; if (k2) *(u32x4*)(nxt + kst1) = rk1; *(u32x4*)(nxt + vst) = rv; }
        __syncthreads();
    }
    bf16_t* dst = (bf16_t*)(p.ws + OFF_RS + S_CAT) + (size_t)(b * S + qb * 256 + wid * 32) * 1024 + h * 64;
    attn_store(o, lrun, af, dst, lane);
}

namespace mla2 {
constexpr int SLK = 12288, SLV = 8192, LDS_K = 0, LDS_V = 4 * SLK, LDS_WS = LDS_V + 3 * SLV, LDS_OST = LDS_WS + 8 * 256, LDS_END = LDS_OST + 8 * 4096;
constexpr int KP = 768, VP = 512, NT = S / 64;
typedef __attribute__((address_space(3))) const char* lds_cptr;
__device__ __forceinline__ void glds16(const void* g, unsigned lds_dst) {
    unsigned keep; asm volatile("s_mov_b32 %0, m0\n\ts_mov_b32 m0, %2\n\ts_nop 0\n\tglobal_load_lds_dwordx4 %1, off\n\ts_mov_b32 m0, %0" : "=&s"(keep) : "v"(g), "s"(lds_dst) : "memory"); }
typedef float f32x2_t __attribute__((ext_vector_type(2))); typedef __bf16 bf16x2_t __attribute__((ext_vector_type(2)));
__device__ __forceinline__ unsigned cvtpk_s(float lo, float hi) { f32x2_t v = {lo, hi}; bf16x2_t b = __builtin_convertvector(v, bf16x2_t); return __builtin_bit_cast(unsigned, b); }
__device__ __forceinline__ void kload2(bf16x8* kf, lds_cptr kp, int j) { kf[2 * j] = *(const __attribute__((address_space(3))) bf16x8*)(kp + j * 2048); kf[2 * j + 1] = *(const __attribute__((address_space(3))) bf16x8*)(kp + j * 2048 + 512); }
__device__ __forceinline__ s16x4 vtr3(lds_cptr pl) { typedef short v4i16_t __attribute__((ext_vector_type(4))); return __builtin_bit_cast(s16x4, __builtin_amdgcn_ds_read_tr16_b64_v4i16((__attribute__((address_space(3))) v4i16_t*)pl)); }
#define M2_SBAR() __builtin_amdgcn_sched_barrier(0)
#define M2_PIN(x) asm volatile("" : "+v"(x))
#define M2_WAIT_BAR(N) asm volatile("s_waitcnt vmcnt(" #N ") lgkmcnt(0)\n\ts_barrier" ::: "memory")
#define M2_MF(a, b, c) __builtin_amdgcn_mfma_f32_32x32x16_bf16(a, b, c, 0, 0, 0)
__device__ __forceinline__ void unit(const bf16_t* Q, const bf16_t* K, const bf16_t* V, bf16_t* O, char* shm, int b, int h, int qb) {
    const int tid = tidx(), lane = tid & 63, r32 = lane & 31, hi = lane >> 5; const int wid = __builtin_amdgcn_readfirstlane(tid >> 6);
    const bool w4 = wid < 4;
    const long rowbase = (long)b * S; const int q0 = qb * 256;
    const bf16_t* Qw = Q + (rowbase + q0 + wid * 32) * KP + h * 96;
    const bf16_t* Kh = K + rowbase * KP + h * 96; const bf16_t* Vh = V + rowbase * VP + h * 64;
    const unsigned lds0 = (unsigned)(uintptr_t)shm;
    float* wsf = (float*)(shm + LDS_WS) + wid * 64;
    const bf16_t* ksrc = Kh + (long)lane * KP + wid * 8;
    const bf16_t* ksrc2 = Kh + (long)lane * KP + (8 + (wid & 3)) * 8;
    const bf16_t* vsrc = Vh + (long)(16 * (wid & 3) + (lane >> 2)) * VP + (wid >> 2) * 32 + (lane & 3) * 8;
    const unsigned kdst = lds0 + LDS_K + wid * 1024, kdst2 = lds0 + LDS_K + (8 + (wid & 3)) * 1024, vdst = lds0 + LDS_V + wid * 1024;
#define M2_DMA_K(t, slot) do { glds16(ksrc + (long)(t) * 64 * KP, (unsigned)__builtin_amdgcn_readfirstlane(kdst + (slot))); if (w4) glds16(ksrc2 + (long)(t) * 64 * KP, (unsigned)__builtin_amdgcn_readfirstlane(kdst2 + (slot))); } while (0)
#define M2_DMA_V(t, slot) glds16(vsrc + (long)(t) * 64 * VP, (unsigned)__builtin_amdgcn_readfirstlane(vdst + (slot)))
#define M2_WAITS() do { if (w4) { M2_WAIT_BAR(3); } else { M2_WAIT_BAR(2); } } while (0)
    const lds_cptr shm3 = (lds_cptr)shm; const lds_cptr kp0 = shm3 + LDS_K + hi * 1024 + r32 * 16;
    const lds_cptr vp0 = shm3 + LDS_V + ((lane >> 4) & 1) * 32 + (lane & 3) * 8 + (4 * hi + ((lane & 15) >> 2)) * 64;
    M2_DMA_K(0, 0); M2_DMA_V(0, 0); M2_DMA_K(1, SLK);
    bf16x8 qr[6];
#pragma unroll
    for (int d0 = 0; d0 < 6; ++d0) qr[d0] = *(const bf16x8*)(Qw + (long)r32 * KP + d0 * 16 + hi * 8);
    float mhat = 0.f, l_reg = 0.f; f32x16 o[2]; o[0] = (f32x16){}; o[1] = (f32x16){}; f32x16 negm = (f32x16){}; M2_PIN(negm);
    bool resc = false;
    f32x16 pA0, pA1, pB0, pB1; bf16x8 kf[12]; s16x4 vlo[8], vhi[8]; u32x4 pw0, pw1, pw2, pw3;
    int vs_prev = 0, vs_cur = 0, vs_next = SLV;
#define M2_ROT() do { vs_prev = vs_cur; vs_cur = vs_next; vs_next = (vs_next == 2 * SLV) ? 0 : vs_next + SLV; } while (0)
#define M2_KS(t) (((t) & 3) * SLK)
    M2_DMA_K(2, 2 * SLK);
    if (w4) { M2_WAIT_BAR(5); } else { M2_WAIT_BAR(3); }
#pragma unroll
    for (int j = 0; j < 6; ++j) kload2(kf, kp0, j);
    pA0 = M2_MF(kf[0], qr[0], negm); pA1 = M2_MF(kf[1], qr[0], negm);
#pragma unroll
    for (int j = 1; j < 6; ++j) { pA0 = M2_MF(kf[2 * j], qr[j], pA0); pA1 = M2_MF(kf[2 * j + 1], qr[j], pA1); }
    {
        float a = MX3(pA0[0], pA0[1], pA1[0]), bq = MX3(pA0[2], pA0[3], pA1[1]); a = MX3(a, pA1[2], pA1[3]);
#pragma unroll
        for (int r = 4; r < 16; r += 4) { a = MX3(a, pA0[r], pA0[r + 1]); bq = MX3(bq, pA0[r + 2], pA0[r + 3]); a = MX3(a, pA1[r], pA1[r + 1]); bq = MX3(bq, pA1[r + 2], pA1[r + 3]); }
        float rm = __builtin_fmaxf(a, bq); { auto rr = __builtin_amdgcn_permlane32_swap(__float_as_uint(rm), __float_as_uint(rm), false, false); rm = __builtin_fmaxf(__uint_as_float(rr[0]), __uint_as_float(rr[1])); }
        mhat = rm;
#pragma unroll
        for (int r = 0; r < 16; ++r) { pA0[r] = __builtin_amdgcn_exp2f(pA0[r] - rm); pA1[r] = __builtin_amdgcn_exp2f(pA1[r] - rm); negm[r] = -mhat; }
        M2_PIN(negm);
    }
    M2_WAIT_BAR(0);
    M2_DMA_K(3, 3 * SLK); M2_DMA_V(1, SLV); M2_ROT();
#pragma unroll
    for (int j = 0; j < 4; ++j) kload2(kf, kp0 + M2_KS(1), j);
#define M2_PKW(P, B) cvtpk_s(P[B], P[B + 1])
#define M2_PAF(k) __builtin_bit_cast(bf16x8, pw##k)
#define M2_VFR(i) (bf16x8){vlo[i][0], vlo[i][1], vlo[i][2], vlo[i][3], vhi[i][0], vhi[i][1], vhi[i][2], vhi[i][3]}
#define M2_VRD(i) do { vlo[i] = vtr3(vp_ + (((i) >> 2) * 4096 + ((i) & 3) * 1024)); vhi[i] = vtr3(vp_ + (((i) >> 2) * 4096 + ((i) & 3) * 1024 + 512)); } while (0)
#define M2_EX(v) __builtin_amdgcn_exp2f(v)
#define M2_GAPB(MF, X, B) do { MF; X[B] = M2_EX(X[B]); X[B + 1] = M2_EX(X[B + 1]); X[B + 2] = M2_EX(X[B + 2]); X[B + 3] = M2_EX(X[B + 3]); M2_PIN(X); M2_SBAR(); } while (0)
#define M2_KRD(G, kb, j) do { if (G) { kload2(kf, kp0 + (kb), j); M2_SBAR(); } } while (0)
#define M2_STEP(C0, C1, P0, P1, t, GK, GV, GL) do { M2_SBAR(); \
    const lds_cptr vp_ = vp0 + vs_prev; const int kc_ = M2_KS(t), kn_ = M2_KS((t) + 1); \
    M2_VRD(0); M2_SBAR(); float sacc = P0[0] + P0[1]; \
    C0 = M2_MF(kf[0], qr[0], negm); sacc += P0[2]; sacc += P0[3]; sacc += P0[4]; M2_PIN(sacc); pw0[0] = M2_PKW(P0, 0); pw0[1] = M2_PKW(P0, 2); M2_PIN(pw0); M2_SBAR(); \
    M2_VRD(4); M2_SBAR(); \
    C1 = M2_MF(kf[1], qr[0], negm); sacc += P0[5]; sacc += P0[6]; sacc += P0[7]; M2_PIN(sacc); pw0[2] = M2_PKW(P0, 4); pw0[3] = M2_PKW(P0, 6); M2_PIN(pw0); M2_SBAR(); \
    M2_VRD(1); M2_SBAR(); \
    C0 = M2_MF(kf[2], qr[1], C0); sacc += P0[8]; sacc += P0[9]; sacc += P0[10]; M2_PIN(sacc); pw1[0] = M2_PKW(P0, 8); pw1[1] = M2_PKW(P0, 10); M2_PIN(pw1); M2_SBAR(); \
    M2_VRD(5); M2_SBAR(); \
    C1 = M2_MF(kf[3], qr[1], C1); sacc += P0[11]; sacc += P0[12]; sacc += P0[13]; M2_PIN(sacc); pw1[2] = M2_PKW(P0, 12); pw1[3] = M2_PKW(P0, 14); M2_PIN(pw1); M2_SBAR(); \
    M2_VRD(2); kload2(kf, kp0 + kc_, 4); M2_SBAR();                                                         \
    C0 = M2_MF(kf[4], qr[2], C0); sacc += P0[14]; sacc += P0[15]; sacc += P1[0]; M2_PIN(sacc); pw2[0] = M2_PKW(P1, 0); M2_PIN(pw2); M2_SBAR(); \
    M2_VRD(6); kload2(kf, kp0 + kc_, 5); M2_SBAR(); \
    C1 = M2_MF(kf[5], qr[2], C1); sacc += P1[1]; sacc += P1[2]; sacc += P1[3]; M2_PIN(sacc); pw2[1] = M2_PKW(P1, 2); M2_PIN(pw2); M2_SBAR(); \
    M2_VRD(3); M2_SBAR(); \
    C0 = M2_MF(kf[6], qr[3], C0); sacc += P1[4]; sacc += P1[5]; M2_PIN(sacc); pw2[2] = M2_PKW(P1, 4); M2_PIN(pw2); M2_SBAR(); \
    M2_VRD(7); M2_SBAR(); \
    C1 = M2_MF(kf[7], qr[3], C1); sacc += P1[6]; sacc += P1[7]; M2_PIN(sacc); pw2[3] = M2_PKW(P1, 6); M2_PIN(pw2); M2_SBAR(); \
    C0 = M2_MF(kf[8], qr[4], C0); sacc += P1[8]; sacc += P1[9]; M2_PIN(sacc); pw3[0] = M2_PKW(P1, 8); M2_PIN(pw3); M2_SBAR(); \
    C1 = M2_MF(kf[9], qr[4], C1); sacc += P1[10]; sacc += P1[11]; M2_PIN(sacc); pw3[1] = M2_PKW(P1, 10); M2_PIN(pw3); M2_SBAR(); \
    C0 = M2_MF(kf[10], qr[5], C0); sacc += P1[12]; sacc += P1[13]; M2_PIN(sacc); pw3[2] = M2_PKW(P1, 12); M2_PIN(pw3); M2_SBAR(); \
    C1 = M2_MF(kf[11], qr[5], C1); sacc += P1[14]; sacc += P1[15]; M2_PIN(sacc); pw3[3] = M2_PKW(P1, 14); M2_PIN(pw3); M2_SBAR(); \
    l_reg += sacc; \
    if (GK) { M2_DMA_K((t) + 3, M2_KS((t) + 3)); } if (GV) { M2_DMA_V((t) + 1, vs_next); } \
    { float a = MX3(C0[0], C0[1], C1[0]), bq = MX3(C0[2], C0[3], C1[1]); a = MX3(a, C1[2], C1[3]); \
      _Pragma("unroll") for (int r = 4; r < 16; r += 4) { a = MX3(a, C0[r], C0[r + 1]); bq = MX3(bq, C0[r + 2], C0[r + 3]); a = MX3(a, C1[r], C1[r + 1]); bq = MX3(bq, C1[r + 2], C1[r + 3]); } \
      float rm = __builtin_fmaxf(a, bq); { auto rr = __builtin_amdgcn_permlane32_swap(__float_as_uint(rm), __float_as_uint(rm), false, false); rm = __builtin_fmaxf(__uint_as_float(rr[0]), __uint_as_float(rr[1])); } \
      resc = false; \
      if (__builtin_expect(__any(rm > ATT_THR), 0)) { const float dl = __builtin_fmaxf(rm, 0.f); mhat += dl; \
        _Pragma("unroll") for (int r = 0; r < 16; ++r) { C0[r] -= dl; C1[r] -= dl; } \
        _Pragma("unroll") for (int r = 0; r < 16; ++r) negm[r] = -mhat; M2_PIN(negm); \
        const float f = __builtin_amdgcn_exp2f(-dl); l_reg *= f; if (hi == 0) wsf[r32] = f; resc = true; } } \
    M2_SBAR(); \
    M2_GAPB(o[0] = M2_MF(M2_PAF(0), M2_VFR(0), o[0]), C0, 0); \
    M2_KRD(GL, kn_, 0); M2_GAPB(o[1] = M2_MF(M2_PAF(0), M2_VFR(4), o[1]), C0, 4); \
    M2_KRD(GL, kn_, 1); M2_GAPB(o[0] = M2_MF(M2_PAF(1), M2_VFR(1), o[0]), C0, 8); \
    M2_KRD(GL, kn_, 2); M2_GAPB(o[1] = M2_MF(M2_PAF(1), M2_VFR(5), o[1]), C0, 12); \
    M2_KRD(GL, kn_, 3); M2_GAPB(o[0] = M2_MF(M2_PAF(2), M2_VFR(2), o[0]), C1, 0); \
    M2_GAPB(o[1] = M2_MF(M2_PAF(2), M2_VFR(6), o[1]), C1, 4); \
    M2_GAPB(o[0] = M2_MF(M2_PAF(3), M2_VFR(3), o[0]), C1, 8); \
    M2_GAPB(o[1] = M2_MF(M2_PAF(3), M2_VFR(7), o[1]), C1, 12); \
    } while (0)
#define M2_RESC() do { if (resc) { asm volatile("s_waitcnt lgkmcnt(0)" ::: "memory"); \
      _Pragma("unroll") for (int d_ = 0; d_ < 2; ++d_) _Pragma("unroll") for (int r = 0; r < 16; ++r) o[d_][r] *= wsf[crow(r, hi)]; } } while (0)
#define M2_ENDW(tt) do { if ((tt) + 3 < NT) { M2_WAITS(); } else if ((tt) + 2 < NT) { M2_WAIT_BAR(1); } else { M2_WAIT_BAR(0); } } while (0)
    M2_WAIT_BAR(0);
    int t = 1;
    for (; t + 5 < NT; t += 2) {
        M2_STEP(pB0, pB1, pA0, pA1, t, true, true, true);     M2_WAITS(); M2_RESC(); M2_ROT();
        M2_STEP(pA0, pA1, pB0, pB1, t + 1, true, true, true); M2_WAITS(); M2_RESC(); M2_ROT();
    }
    for (; t + 1 < NT; t += 2) {
        M2_STEP(pB0, pB1, pA0, pA1, t, (t + 3 < NT), (t + 1 < NT), (t + 1 < NT));         M2_ENDW(t);     M2_RESC(); M2_ROT();
        M2_STEP(pA0, pA1, pB0, pB1, t + 1, (t + 4 < NT), (t + 2 < NT), (t + 2 < NT));     M2_ENDW(t + 1); M2_RESC(); M2_ROT();
    }
    M2_STEP(pB0, pB1, pA0, pA1, NT - 1, false, false, false); M2_RESC();
    {
        float sacc = pB0[0] + pB0[1];
#pragma unroll
        for (int r = 2; r < 16; ++r) sacc += pB0[r];
#pragma unroll
        for (int r = 0; r < 16; ++r) sacc += pB1[r];
        l_reg += sacc;
        pw0 = (u32x4){M2_PKW(pB0, 0), M2_PKW(pB0, 2), M2_PKW(pB0, 4), M2_PKW(pB0, 6)}; pw1 = (u32x4){M2_PKW(pB0, 8), M2_PKW(pB0, 10), M2_PKW(pB0, 12), M2_PKW(pB0, 14)};
        pw2 = (u32x4){M2_PKW(pB1, 0), M2_PKW(pB1, 2), M2_PKW(pB1, 4), M2_PKW(pB1, 6)}; pw3 = (u32x4){M2_PKW(pB1, 8), M2_PKW(pB1, 10), M2_PKW(pB1, 12), M2_PKW(pB1, 14)};
        const lds_cptr vp_ = vp0 + vs_cur;
#pragma unroll
        for (int i = 0; i < 8; ++i) M2_VRD(i);
        o[0] = M2_MF(M2_PAF(0), M2_VFR(0), o[0]); o[1] = M2_MF(M2_PAF(0), M2_VFR(4), o[1]); o[0] = M2_MF(M2_PAF(1), M2_VFR(1), o[0]); o[1] = M2_MF(M2_PAF(1), M2_VFR(5), o[1]);
        o[0] = M2_MF(M2_PAF(2), M2_VFR(2), o[0]); o[1] = M2_MF(M2_PAF(2), M2_VFR(6), o[1]); o[0] = M2_MF(M2_PAF(3), M2_VFR(3), o[0]); o[1] = M2_MF(M2_PAF(3), M2_VFR(7), o[1]);
    }
    { auto rr = __builtin_amdgcn_permlane32_swap(__float_as_uint(l_reg), __float_as_uint(l_reg), false, false); l_reg = __uint_as_float(rr[0]) + __uint_as_float(rr[1]); }
    if (hi == 0) wsf[32 + r32] = l_reg;
    asm volatile("s_waitcnt lgkmcnt(0)" ::: "memory");
    float rli[16];
#pragma unroll
    for (int r = 0; r < 16; ++r) rli[r] = __builtin_amdgcn_rcpf(wsf[32 + crow(r, hi)]);
    bf16_t* Ow = O + (rowbase + q0 + wid * 32) * 1024 + h * 64; bf16_t* stg = (bf16_t*)(shm + LDS_OST) + wid * 2048;
#pragma unroll
    for (int r = 0; r < 16; ++r) { const int orow = crow(r, hi);
#pragma unroll
        for (int d0 = 0; d0 < 2; ++d0) stg[orow * 64 + d0 * 32 + r32] = f2bf(o[d0][r] * rli[r]); }
    asm volatile("s_waitcnt lgkmcnt(0)" ::: "memory");
#pragma unroll
    for (int i = 0; i < 4; ++i) { const int row = i * 8 + (lane >> 3), ch = lane & 7; *(u32x4*)(Ow + (long)row * 1024 + ch * 8) = *(const u32x4*)(stg + row * 64 + ch * 8); }
    asm volatile("s_waitcnt lgkmcnt(0)\n\ts_barrier" ::: "memory");
#undef M2_DMA_K
#undef M2_DMA_V
#undef M2_WAITS
#undef M2_ROT
#undef M2_KS
#undef M2_PKW
#undef M2_PAF
#undef M2_VFR
#undef M2_VRD
#undef M2_EX
#undef M2_GAPB
#undef M2_KRD
#undef M2_STEP
#undef M2_RESC
#undef M2_ENDW
}
}

constexpr int SWA_KROW = 144, SWA_KB = 384 * SWA_KROW, SWA_VB = 2 * 384 * 64, SWA_BIAS = SWA_KB + SWA_VB, SWA_AF = SWA_BIAS + 4 * 512 * 4;
__device__ __forceinline__ void swa_unit(const Params& p, char* lds, int b, int nblk, int g) {
    const int tid = tidx(), lane = tid & 63, wid = tid >> 6, r32 = lane & 31, hi = lane >> 5;
    const bf16_t* qb = (const bf16_t*)(p.ws + OFF_RS + S_QB);
    const bf16_t* kb = (const bf16_t*)(p.ws + OFF_RS + S_KB);
    const bf16_t* vb = (const bf16_t*)(p.ws + OFF_RS + S_VB);
    float* af = (float*)(lds + SWA_AF) + wid * 32;
    float* bl = (float*)(lds + SWA_BIAS);
#pragma unroll
    for (int id = tid; id < 384 * 8; id += NTHR) {
        const int row = id >> 3, c = id & 7, pos = nblk * 128 - 128 + row;
        const bool ok = pos >= 0 && pos < S; const int pp = ok ? pos : 0;
        u32x4 kv = *(const u32x4*)(kb + (size_t)(b * S + pp) * 128 + g * 64 + c * 8), vv = *(const u32x4*)(vb + (size_t)(b * S + pp) * 128 + g * 64 + c * 8);
        if (!ok) { kv = (u32x4){0u, 0u, 0u, 0u}; vv = kv; }
        *(u32x4*)(lds + row * SWA_KROW + c * 16) = kv;
        *(u32x4*)(lds + SWA_KB + (c >> 2) * (384 * 64) + row * 64 + (c & 3) * 16) = vv;
    }
    {
        const float* bt = (const float*)(p.ws + OFF_MISC + M_BIAS);
#pragma unroll
        for (int id = tid; id < 4 * 512; id += NTHR) { const int hl = id >> 9, rel = (id & 511) - 255; bl[id] = (rel >= -128 && rel <= 128) ? bt[(g * 4 + hl) * 257 + rel + 128] : -INFINITY; }
    }
    __syncthreads();
    const int hl = wid >> 1, hh = g * 4 + hl;
    const float sinkv = p.l0_sinks[hh] * LOG2E;
    for (int sb = 0; sb < 2; ++sb) {
        const int qoff = (wid & 1) * 64 + sb * 32;
        const int qrow = b * S + nblk * 128 + qoff;
        bf16x8 qf[4];
        {
            const bf16_t* qp = qb + (size_t)(qrow + r32) * 512 + hh * 64 + hi * 8;
#pragma unroll
            for (int ks = 0; ks < 4; ++ks) qf[ks] = *(const bf16x8*)(qp + ks * 16);
        }
        float mrun = sinkv, lrun = hi == 0 ? 1.0f : 0.0f;
        f32x16 cinit;
#pragma unroll
        for (int r = 0; r < 16; ++r) cinit[r] = -sinkv;
        f32x16 o[2]; o[0] = (f32x16){}; o[1] = (f32x16){};
        const int qi = qoff + r32;
        for (int kt = 0; kt < 6; ++kt) {
            const int k0 = kt * 64;
            if (k0 - 128 - (qoff + 31) > 128 || k0 + 63 - 128 - qoff < -128) continue;
            if ((nblk == 0 && kt < 2) || (nblk == 63 && kt >= 4)) continue;
            f32x16 s0 = cinit, s1 = cinit;
#pragma unroll
            for (int ks = 0; ks < 4; ++ks) {
                const bf16x8 ka = *(const bf16x8*)(lds + (k0 + r32) * SWA_KROW + (ks * 2 + hi) * 16);
                const bf16x8 kb2 = *(const bf16x8*)(lds + (k0 + 32 + r32) * SWA_KROW + (ks * 2 + hi) * 16);
                s0 = MFMA32(ka, qf[ks], s0); s1 = MFMA32(kb2, qf[ks], s1);
            }
            {
                const float* bp = bl + hl * 512 + (k0 - 128 - qi + 4 * hi + 255);
#pragma unroll
                for (int r = 0; r < 16; ++r) { const int o_ = (r & 3) + 8 * (r >> 2); s0[r] += bp[o_]; s1[r] += bp[o_ + 32]; }
            }
            softmax_pv(s0, s1, mrun, lrun, o, cinit, false, lds + SWA_KB + k0 * 64, 384 * 64, af, lane);
        }
        bf16_t* dst = (bf16_t*)(p.ws + OFF_RS + S_CAT) + (size_t)qrow * 1024 + 512 + hh * 64;
        attn_store(o, lrun, af, dst, lane);
    }
    __syncthreads();
}
__device__ __forceinline__ void phase_attn(const Params& p, char* lds) {
    for (int u = blockIdx.x; u < 512 + 256; u += gridDim.x) {
        if (u < 512) {
            const int h = u & 7, qb = (u >> 3) & 31, b = u >> 8;
            if constexpr (MLA_V2) mla2::unit((const bf16_t*)p.out, (const bf16_t*)((const char*)p.out + 24 * MiB), (const bf16_t*)(p.ws + OFF_RS + S_V), (bf16_t*)(p.ws + OFF_RS + S_CAT), lds, b, h, qb);
            else mla_unit(p, lds, b, h, qb);
        }
        else { const int v = u - 512; const int g = v & 1, nblk = (v >> 1) & 63, b = v >> 7; swa_unit(p, lds, b, nblk, g); }
    }
}

struct EpiRes {
    static constexpr bool PERM = true;
    const bf16_t* res; bf16_t* dst;
    __device__ __forceinline__ void operator()(f32x4 (&acc)[2][2][4][2], const pg8::Unit& u, int wr, int wc, int fr, int fq) const {
#pragma unroll
        for (int ai = 0; ai < 2; ++ai) {
            u32x4 rr[4][2];
#pragma unroll
            for (int m = 0; m < 4; ++m)
#pragma unroll
                for (int bj = 0; bj < 2; ++bj) rr[m][bj] = *(const u32x4*)(res + (size_t)(u.pm * 256 + ai * 128 + wr * 64 + m * 16 + fr) * 1024 + u.pn * 256 + wc * 32 + fq * 8 + bj * 128);
#pragma unroll
            for (int m = 0; m < 4; ++m) {
                const size_t off = (size_t)(u.pm * 256 + ai * 128 + wr * 64 + m * 16 + fr) * 1024 + u.pn * 256 + wc * 32 + fq * 8;
#pragma unroll
                for (int bj = 0; bj < 2; ++bj) {
                    const size_t o = off + bj * 128; const u32x4 r = rr[m][bj]; const f32x4 a0 = acc[ai][bj][m][0], a1 = acc[ai][bj][m][1]; f32x4 v0, v1;
                    v0[0] = __uint_as_float(r.x << 16) * ALPHA + a0[0]; v0[1] = __uint_as_float(r.x & 0xffff0000u) * ALPHA + a0[1];
                    v0[2] = __uint_as_float(r.y << 16) * ALPHA + a0[2]; v0[3] = __uint_as_float(r.y & 0xffff0000u) * ALPHA + a0[3];
                    v1[0] = __uint_as_float(r.z << 16) * ALPHA + a1[0]; v1[1] = __uint_as_float(r.z & 0xffff0000u) * ALPHA + a1[1];
                    v1[2] = __uint_as_float(r.w << 16) * ALPHA + a1[2]; v1[3] = __uint_as_float(r.w & 0xffff0000u) * ALPHA + a1[3];
                    const u32x2 lo = pk4(v0), hi2 = pk4(v1);
                    *(u32x4*)(dst + o) = (u32x4){lo.x, lo.y, hi2.x, hi2.y};
                }
            }
        }
    }
};
__device__ __forceinline__ void phase_outproj(const Params& p, char* lds, const bf16_t* A, const bf16_t* Wt, const bf16_t* res, bf16_t* dst) {
    pg8::StaticOrder so; so.init(T, 1024, gridDim.x, blockIdx.x);
    EpiRes e{res, dst};
    pg8::gemm_phase(lds, A, Wt, 1024, so, pg8::DenseRows{}, e);
}

__device__ __forceinline__ void phase_ln_router(const Params& p, char* lds, const bf16_t* src, bf16_t* hb, const float* g, const float* bta, int layer) {
    const int tid = tidx(), lane = tid & 63, wid = tid >> 6, r16 = lane & 15, fq = lane >> 4;
    bf16_t* wbh = (bf16_t*)lds;
    bf16_t* wbl = (bf16_t*)(lds + 32768);
    float* gbl = (float*)(lds + 65536);
    int* lcnt = (int*)(lds + 73728);
    int* lbase = lcnt + 16;
    int* sel = lbase + 16;
    float* selw = (float*)(sel + 128);
    float* lgs = (float*)(lds + 73728 + 2048);
    {
        f32x4 rw[8];
#pragma unroll
        for (int k = 0; k < 8; ++k) rw[k] = *(const f32x4*)(p.router_w + (size_t)(tid + k * NTHR) * 4);
#pragma unroll
        for (int k = 0; k < 8; ++k) { const int i4 = tid + k * NTHR, kk = i4 >> 2, e0 = (i4 & 3) * 4;
            const int base = (((kk >> 5) * 4 + ((kk >> 3) & 3)) * 16) * 8 + (kk & 7);
#pragma unroll
            for (int j = 0; j < 4; ++j) { const float w = rw[k][j]; const bf16_t h = f2bf(w); wbh[base + (e0 + j) * 8] = h; wbl[base + (e0 + j) * 8] = f2bf(w - bf2f(h)); } }
        for (int i = tid; i < 256; i += NTHR) { *(f32x4*)(gbl + i * 4) = *(const f32x4*)(g + i * 4); *(f32x4*)(gbl + 1024 + i * 4) = *(const f32x4*)(bta + i * 4); }
    }
    if (tid < 16) lcnt[tid] = 0;
    __syncthreads();
    int* cnt = (int*)(p.ws + OFF_MISC + M_CNT) + layer * 16;
    int* list = (int*)(p.ws + OFF_MISC + M_LIST);
    float* gatew = (float*)(p.ws + OFF_MISC + M_GATEW);
    float* lgs2 = lgs + 1024;
    float2* part = (float2*)(lds + 73728 + 2048 + 8192);
    const int tg = __builtin_amdgcn_readfirstlane(wid & 3), kh = __builtin_amdgcn_readfirstlane(wid >> 2);
    for (int chunk = blockIdx.x; chunk < T / 64; chunk += gridDim.x) {
        {
            const int tl16 = tg * 16 + r16;
            const size_t tok = (size_t)(chunk * 64 + tl16);
            const bf16_t* rowp = src + tok * 1024 + kh * 512 + fq * 8;
            float sm = 0.f, sq = 0.f;
            u32x4 raw[16];
#pragma unroll
            for (int s_ = 0; s_ < 16; ++s_) raw[s_] = *(const u32x4*)(rowp + s_ * 32);
#pragma unroll
            for (int s_ = 0; s_ < 16; ++s_) {
                const u32x4 v = raw[s_];
#pragma unroll
                for (int j = 0; j < 4; ++j) { const float a = __uint_as_float(v[j] << 16), b = __uint_as_float(v[j] & 0xffff0000u); sm += a + b; sq = __builtin_fmaf(a, a, __builtin_fmaf(b, b, sq)); }
            }
            sm += __shfl_xor(sm, 16); sq += __shfl_xor(sq, 16); sm += __shfl_xor(sm, 32); sq += __shfl_xor(sq, 32);
            if (fq == 0) part[kh * 64 + tl16] = make_float2(sm, sq);
            __syncthreads();
            { const float2 p0 = part[tl16], p1 = part[64 + tl16]; sm = p0.x + p1.x; sq = p0.y + p1.y; }
            const float mu = sm * (1.0f / 1024.0f);
            const float rstd = rsqrtf(fmaxf(sq * (1.0f / 1024.0f) - mu * mu, 0.0f) + LN_EPS);
            const float nmr = -mu * rstd;
            f32x4 acc = (f32x4){0.f, 0.f, 0.f, 0.f};
            bf16_t* hrow = hb + tok * 1024 + kh * 512 + fq * 8;
#pragma unroll
            for (int s_ = 0; s_ < 16; ++s_) {
                const int sg = kh * 16 + s_;
                const u32x4 v = raw[s_];
                const f32x4 g0 = *(const f32x4*)(gbl + sg * 32 + fq * 8), g1 = *(const f32x4*)(gbl + sg * 32 + fq * 8 + 4);
                const f32x4 b0 = *(const f32x4*)(gbl + 1024 + sg * 32 + fq * 8), b1 = *(const f32x4*)(gbl + 1024 + sg * 32 + fq * 8 + 4);
                float y[8];
#pragma unroll
                for (int j = 0; j < 4; ++j) {
                    const float a = __uint_as_float(v[j] << 16), b = __uint_as_float(v[j] & 0xffff0000u);
                    const float ga = j < 2 ? g0[2 * j] : g1[2 * j - 4], gb2 = j < 2 ? g0[2 * j + 1] : g1[2 * j - 3];
                    const float ba = j < 2 ? b0[2 * j] : b1[2 * j - 4], bb2 = j < 2 ? b0[2 * j + 1] : b1[2 * j - 3];
                    y[2 * j] = __builtin_fmaf(__builtin_fmaf(a, rstd, nmr), ga, ba); y[2 * j + 1] = __builtin_fmaf(__builtin_fmaf(b, rstd, nmr), gb2, bb2);
                }
                u32x4 hi, lo;
#pragma unroll
                for (int j = 0; j < 4; ++j) {
                    hi[j] = pk2(y[2 * j], y[2 * j + 1]);
                    lo[j] = pk2(y[2 * j] - __uint_as_float(hi[j] << 16), y[2 * j + 1] - __uint_as_float(hi[j] & 0xffff0000u));
                }
                *(u32x4*)(hrow + s_ * 32) = hi;
                const bf16x8 bh = *(const bf16x8*)(wbh + ((sg * 4 + fq) * 16 + r16) * 8), bl = *(const bf16x8*)(wbl + ((sg * 4 + fq) * 16 + r16) * 8);
                const bf16x8 ah = __builtin_bit_cast(bf16x8, hi), al = __builtin_bit_cast(bf16x8, lo);
                acc = MFMA16(bh, ah, acc); acc = MFMA16(bh, al, acc); acc = MFMA16(bl, ah, acc);
            }
            *(f32x4*)((kh ? lgs2 : lgs) + tl16 * 16 + fq * 4) = acc;
        }
        __syncthreads();
        {
            const int tl = wid * 8 + (lane >> 3);
            float lg[16];
#pragma unroll
            for (int e4 = 0; e4 < 4; ++e4) { const f32x4 t4 = *(const f32x4*)(lgs + tl * 16 + e4 * 4) + *(const f32x4*)(lgs2 + tl * 16 + e4 * 4); lg[e4 * 4] = t4[0]; lg[e4 * 4 + 1] = t4[1]; lg[e4 * 4 + 2] = t4[2]; lg[e4 * 4 + 3] = t4[3]; }
            float sc[16], bs[16];
#pragma unroll
            for (int e = 0; e < 16; ++e) { sc[e] = fsigmoid(lg[e]); bs[e] = sc[e] + p.router_bias[e]; }
            int gsel = 0; float gbest = -INFINITY;
#pragma unroll
            for (int gq = 0; gq < 4; ++gq) {
                float m1 = -INFINITY, m2 = -INFINITY;
#pragma unroll
                for (int e = 0; e < 4; ++e) { const float x = bs[gq * 4 + e]; if (x > m1) { m2 = m1; m1 = x; } else if (x > m2) m2 = x; }
                const float gs = m1 + m2;
                if (gs > gbest) { gbest = gs; gsel = gq; }
            }
            float b0 = -INFINITY, b1 = -INFINITY, w0 = 0.f, w1 = 0.f; int e0 = 0, e1 = 0;
#pragma unroll
            for (int e = 0; e < 16; ++e) {
                if ((e >> 2) == gsel) {
                    const float x = bs[e];
                    if (x > b0) { b1 = b0; e1 = e0; w1 = w0; b0 = x; e0 = e; w0 = sc[e]; }
                    else if (x > b1) { b1 = x; e1 = e; w1 = sc[e]; }
                }
            }
            const float inv = 1.0f / (w0 + w1);
            if ((lane & 7) == 0) {
                const int l0 = atomicAdd(&lcnt[e0], 1), l1 = atomicAdd(&lcnt[e1], 1);
                sel[tl * 2] = e0 | (l0 << 8); sel[tl * 2 + 1] = e1 | (l1 << 8);
                selw[tl * 2] = w0 * inv; selw[tl * 2 + 1] = w1 * inv;
            }
        }
        __syncthreads();
        if (tid < 16) lbase[tid] = atomicAdd(&cnt[tid], lcnt[tid]);
        __syncthreads();
        if (tid < 128) {
            const int sv = sel[tid], e = sv & 255, lp = sv >> 8, tk = (chunk * 64 + (tid >> 1)) * 2 + (tid & 1);
            list[e * T + lbase[e] + lp] = tk;
            gatew[tk] = selw[tid];
        }
        __syncthreads();
        if (tid < 16) lcnt[tid] = 0;
        __syncthreads();
    }
}

constexpr size_t M_READY = 1024;
struct MoeOrder {
    typedef int i32x2 __attribute__((ext_vector_type(2)));
    typedef __attribute__((address_space(3))) i32x2 LdsInt2;
    const int* list; int* ready; int G, c, nmt; bool down; mutable int pend; const LdsInt2* tab;
    __device__ void init(char* lds, const int* cnt_, const int* list_, int* ready_, int G_, int c_, bool down_) {
        list = list_; ready = ready_; G = G_; c = c_; down = down_; pend = -1;
        typedef __attribute__((address_space(3))) int LdsInt;
        LdsInt2* tb = (LdsInt2*)(__attribute__((address_space(3))) char*)(lds + LDS_MTAB); LdsInt* cn = (LdsInt*)(__attribute__((address_space(3))) char*)(lds + LDS_MTAB + 160 * 8);
        tab = tb;
        const int tid = tidx();
        __syncthreads();
        if (tid < 16) cn[tid] = cnt_[tid];
        __syncthreads();
        int n = 0, me = -1, mr0 = 0, mv = 0;
#pragma unroll
        for (int e = 0; e < 16; ++e) {
            const int cv = cn[e], ne = (cv + 255) >> 8;
            if (tid >= n && tid < n + ne) { me = e; mr0 = (tid - n) * 256; mv = min(256, cv - mr0); }
            n += ne;
        }
        nmt = n;
        if (me >= 0 && tid < 160) { i32x2 en; en.x = me * T + mr0; en.y = me | (mv << 8); tb[tid] = en; }
        __syncthreads();
    }
    __device__ bool next(int i, pg8::Unit& u) const {
        const int nwg = nmt * 4; long L = (long)i * G + c;
        if (down) {
            const int nf = nwg / G, r = nwg - nf * G;
            if (nf == 2 && r > 0 && 3 * r <= G) {
                if (c >= r) L = i == 0 ? c - r : (i == 1 ? (G - r) + (c - r) : ((i == 2 && c < 3 * r) ? 2 * (G - r) + r + (c - r) : nwg));
                else L = i == 0 ? 2 * (G - r) + c : nwg;
            }
        }
        if (L >= nwg) return false;
        int wgid = (int)L; { const int q = nwg / 8, r = nwg % 8, xcd = wgid % 8, off = wgid / 8; wgid = (xcd < r ? xcd * (q + 1) : r * (q + 1) + (xcd - r) * q) + off; }
        const int mtile = wgid >> 2;
        const i32x2 en = tab[mtile];
        const int ex = __builtin_amdgcn_readfirstlane(en.x), ey = __builtin_amdgcn_readfirstlane(en.y);
        u.pm = mtile; u.e = ey & 255; u.pn = u.e * 4 + (wgid & 3); u.valid = ey >> 8; u.lst = list + ex;
        return true;
    }
    __device__ __forceinline__ void a_ready(const pg8::Unit& u) const {
        if (!down) return;
        if (threadIdx.x < 64) {
            unsigned sp = 0;
            while (__builtin_amdgcn_readfirstlane(__hip_atomic_load(ready + u.pm, __ATOMIC_RELAXED, __HIP_MEMORY_SCOPE_AGENT)) < 32) {
                __builtin_amdgcn_s_sleep(2);
                if (++sp > (1u << 22)) break;
            }
            __builtin_amdgcn_fence(__ATOMIC_ACQUIRE, "agent");
            asm volatile("s_waitcnt vmcnt(0)" ::: "memory");
        }
        asm volatile("" ::: "memory"); __builtin_amdgcn_s_barrier(); asm volatile("" ::: "memory");
    }
    __device__ __forceinline__ void done(const pg8::Unit& u) const {
        if (down) return;
        asm volatile("s_waitcnt vmcnt(0)" ::: "memory");
        if ((threadIdx.x & 63) == 0) __hip_atomic_fetch_add(ready + u.pm, 1, __ATOMIC_RELAXED, __HIP_MEMORY_SCOPE_AGENT);
    }
};
struct GatherRows { int sh; __device__ __forceinline__ unsigned rowoff(const pg8::Unit& u, int row, int K) const { return (unsigned)(u.lst[min(row, u.valid - 1)] >> sh) * (unsigned)K * 2u; } };
constexpr bool MOE_MERGED = false;
struct EpiMoeUp {
    static constexpr bool PERM = true;
    bf16_t* H;
    __device__ __forceinline__ void operator()(f32x4 (&acc)[2][2][4][2], const pg8::Unit& u, int wr, int wc, int fr, int fq) const {
        const int pnl = u.pn & 3;
        int tks[2][4];
#pragma unroll
        for (int ai = 0; ai < 2; ++ai)
#pragma unroll
            for (int m = 0; m < 4; ++m) tks[ai][m] = u.lst[min(ai * 128 + wr * 64 + m * 16 + fr, u.valid - 1)];
#pragma unroll
        for (int ai = 0; ai < 2; ++ai)
#pragma unroll
            for (int m = 0; m < 4; ++m) {
                const int r = ai * 128 + wr * 64 + m * 16 + fr;
                if (r < u.valid) {
                    const int tk = tks[ai][m];
                    f32x4 o0, o1;
#pragma unroll
                    for (int k = 0; k < 4; ++k) { const float a = acc[ai][0][m][0][k], b = acc[ai][0][m][1][k]; o0[k] = a * fsigmoid(a) * b; }
#pragma unroll
                    for (int k = 0; k < 4; ++k) { const float a = acc[ai][1][m][0][k], b = acc[ai][1][m][1][k]; o1[k] = a * fsigmoid(a) * b; }
                    const u32x2 lo = pk4(o0), hi2 = pk4(o1);
                    {
                        const unsigned long long ha = (unsigned long long)(H + (size_t)tk * 512 + ((pnl * 4 + wc) * 4 + fq) * 8);
                        const u32x4 hv = (u32x4){lo.x, lo.y, hi2.x, hi2.y};
                        if constexpr (MOE_MERGED) asm volatile("global_store_dwordx4 %0, %1, off sc1" :: "v"(ha), "v"(hv) : "memory"); else *(u32x4*)ha = hv;
                    }
                }
            }
    }
};
struct EpiMoeDn {
    static constexpr bool PERM = true;
    bf16_t* Y; const float* gw;
    __device__ __forceinline__ void operator()(f32x4 (&acc)[2][2][4][2], const pg8::Unit& u, int wr, int wc, int fr, int fq) const {
        const int pnl = u.pn & 3;
        int tks[2][4]; float gts[2][4];
#pragma unroll
        for (int ai = 0; ai < 2; ++ai)
#pragma unroll
            for (int m = 0; m < 4; ++m) tks[ai][m] = u.lst[min(ai * 128 + wr * 64 + m * 16 + fr, u.valid - 1)];
#pragma unroll
        for (int ai = 0; ai < 2; ++ai)
#pragma unroll
            for (int m = 0; m < 4; ++m) gts[ai][m] = gw[tks[ai][m]];
#pragma unroll
        for (int ai = 0; ai < 2; ++ai)
#pragma unroll
            for (int m = 0; m < 4; ++m) {
                const int r = ai * 128 + wr * 64 + m * 16 + fr;
                if (r < u.valid) {
                    const int tk = tks[ai][m]; const float gt = gts[ai][m];
                    bf16_t* dst = Y + (size_t)tk * 1024 + pnl * 256 + wc * 32 + fq * 8;
#pragma unroll
                    for (int bj = 0; bj < 2; ++bj) { const u32x2 lo = pk4(acc[ai][bj][m][0] * gt), hi2 = pk4(acc[ai][bj][m][1] * gt); *(u32x4*)(dst + bj * 128) = (u32x4){lo.x, lo.y, hi2.x, hi2.y}; }
                }
            }
    }
};
__device__ __forceinline__ void phase_moe(const Params& p, char* lds, int layer, int which) {
    const int* cnt = (const int*)(p.ws + OFF_MISC + M_CNT) + layer * 16; const int* list = (const int*)(p.ws + OFF_MISC + M_LIST);
    int* ready = (int*)(p.ws + OFF_MISC + M_READY) + layer * 160;
    MoeOrder mo; mo.init(lds, cnt, list, ready, gridDim.x, blockIdx.x, false);
    if (which == 0) {
        EpiMoeUp e{(bf16_t*)(p.ws + OFF_RS + S_HMOE)};
        pg8::gemm_phase<false>(lds, (const bf16_t*)(p.ws + OFF_RA), (const bf16_t*)(p.ws + OFF_WMOE + W_UP), 1024, mo, GatherRows{1}, e);
    } else {
        EpiMoeDn e{(bf16_t*)(p.ws + OFF_RS + S_Y), (const float*)(p.ws + OFF_MISC + M_GATEW)};
        pg8::gemm_phase<false>(lds, (const bf16_t*)(p.ws + OFF_RS + S_HMOE), (const bf16_t*)(p.ws + OFF_WMOE + W_DN), 512, mo, GatherRows{0}, e);
    }
}
struct Ln2Row { u32x4 h[2], y0[2], y1[2]; };
__device__ __forceinline__ void ln2_load(Ln2Row& r, const bf16_t* hb, const bf16_t* Y, int tok, int lane) {
#pragma unroll
    for (int i = 0; i < 2; ++i) {
        const int c = (i * 64 + lane) * 8;
        r.h[i] = *(const u32x4*)(hb + (size_t)tok * 1024 + c);
        r.y0[i] = *(const u32x4*)(Y + (size_t)(2 * tok) * 1024 + c);
        r.y1[i] = *(const u32x4*)(Y + (size_t)(2 * tok + 1) * 1024 + c);
    }
}
__device__ __forceinline__ void phase_ln2(const Params& p, const bf16_t* hb, float* dstf, bf16_t* dstb, const float* g, const float* bta) {
    const int lane = tidx() & 63, wid = __builtin_amdgcn_readfirstlane(tidx() >> 6);
    const bf16_t* Y = (const bf16_t*)(p.ws + OFF_RS + S_Y);
    f32x2 gv[2][4], bv[2][4];
#pragma unroll
    for (int i = 0; i < 2; ++i)
#pragma unroll
        for (int j = 0; j < 4; ++j) { const int c = (i * 64 + lane) * 8 + 2 * j; gv[i][j] = *(const f32x2*)(g + c); bv[i][j] = *(const f32x2*)(bta + c); }
    auto row = [&](const Ln2Row& cur, int tok) __attribute__((always_inline)) {
        f32x2 v[2][4];
        f32x2 s2 = {0.f, 0.f};
#pragma unroll
        for (int i = 0; i < 2; ++i)
#pragma unroll
            for (int j = 0; j < 4; ++j) {
                const unsigned hr = cur.h[i][j], a0 = cur.y0[i][j], a1 = cur.y1[i][j];
                const f32x2 h = {__uint_as_float(hr << 16), __uint_as_float(hr & 0xffff0000u)};
                const f32x2 ya = {__uint_as_float(a0 << 16), __uint_as_float(a0 & 0xffff0000u)}, yb = {__uint_as_float(a1 << 16), __uint_as_float(a1 & 0xffff0000u)};
                v[i][j] = __builtin_elementwise_fma(h, (f32x2){ALPHA, ALPHA}, ya + yb);
                s2 += v[i][j];
            }
        const float mu = wave_sum(s2.x + s2.y) * (1.0f / 1024.0f);
        f32x2 q2 = {0.f, 0.f};
#pragma unroll
        for (int i = 0; i < 2; ++i)
#pragma unroll
            for (int j = 0; j < 4; ++j) { v[i][j] = v[i][j] - (f32x2){mu, mu}; q2 = __builtin_elementwise_fma(v[i][j], v[i][j], q2); }
        const float rstd = rsqrtf(wave_sum(q2.x + q2.y) * (1.0f / 1024.0f) + LN_EPS);
#pragma unroll
        for (int i = 0; i < 2; ++i) {
            const int c = (i * 64 + lane) * 8;
            f32x2 o[4];
#pragma unroll
            for (int j = 0; j < 4; ++j) o[j] = __builtin_elementwise_fma(v[i][j] * (f32x2){rstd, rstd}, gv[i][j], bv[i][j]);
            if (dstf) {
                *(f32x4*)(dstf + (size_t)tok * 1024 + c) = (f32x4){o[0].x, o[0].y, o[1].x, o[1].y};
                *(f32x4*)(dstf + (size_t)tok * 1024 + c + 4) = (f32x4){o[2].x, o[2].y, o[3].x, o[3].y};
            }
            if (dstb) *(u32x4*)(dstb + (size_t)tok * 1024 + c) = (u32x4){pk2(o[0].x, o[0].y), pk2(o[1].x, o[1].y), pk2(o[2].x, o[2].y), pk2(o[3].x, o[3].y)};
        }
    };
    const int stride = gridDim.x * 8;
    int tok = blockIdx.x * 8 + wid;
    Ln2Row ra, rb;
    if (tok < T) ln2_load(ra, hb, Y, tok, lane);
    while (tok < T) {
        ln2_load(rb, hb, Y, tok + stride < T ? tok + stride : tok, lane);
        __builtin_amdgcn_sched_barrier(0);
        row(ra, tok);
        tok += stride;
        if (tok >= T) break;
        ln2_load(ra, hb, Y, tok + stride < T ? tok + stride : tok, lane);
        __builtin_amdgcn_sched_barrier(0);
        row(rb, tok);
        tok += stride;
    }
}

struct EpiIn1 {
    static constexpr bool PERM = true;
    const Params& p;
    __device__ __forceinline__ void operator()(f32x4 (&acc)[2][2][4][2], const pg8::Unit& u, int wr, int wc, int fr, int fq) const {
        bf16_t* gg = (bf16_t*)(p.ws + OFF_RS + S_GG);
        bf16_t* xr = (bf16_t*)(p.ws + OFF_RS + S_XR);
#pragma unroll
        for (int ai = 0; ai < 2; ++ai)
#pragma unroll
            for (int m = 0; m < 4; ++m) {
                const int row = u.pm * 256 + ai * 128 + wr * 64 + m * 16 + fr;
#pragma unroll
                for (int bj = 0; bj < 2; ++bj) {
                    const int seg = 2 * u.pn + bj;
                    f32x4 v0 = acc[ai][bj][m][0], v1 = acc[ai][bj][m][1];
                    bf16_t* dst;
                    if (seg < 8) {
                        dst = gg + (size_t)row * 1024 + seg * 128 + wc * 32 + fq * 8;
#pragma unroll
                        for (int k = 0; k < 4; ++k) { v0[k] = gelu_tanh(v0[k]); v1[k] = gelu_tanh(v1[k]); }
                    } else dst = xr + (size_t)row * 1024 + (seg - 8) * 128 + wc * 32 + fq * 8;
                    const u32x2 lo = pk4(v0), hi2 = pk4(v1);
                    *(u32x4*)dst = (u32x4){lo.x, lo.y, hi2.x, hi2.y};
                }
            }
    }
};
__device__ __forceinline__ void phase_in1(const Params& p, char* lds) {
    pg8::StaticOrder so; so.init(T, 2048, gridDim.x, blockIdx.x);
    EpiIn1 e{p};
    pg8::gemm_phase(lds, (const bf16_t*)(p.ws + OFF_RA), (const bf16_t*)(p.ws + OFF_WS + W_IN1), 1024, so, pg8::DenseRows{}, e);
}
constexpr int LC = 64, NCH = S / LC;
constexpr int SC_XC = 0, SC_GI = 32768;
__device__ __forceinline__ float lam_c(float lam) { return -8.0f * log1pf(expf(-lam)); }
__device__ __forceinline__ void lru_ab(float c8, float r, float ix, float& a, float& b) {
    const float la = c8 * r; a = __expf(la); b = sqrtf(fmaxf(1.0f - a * a, 0.0f)) * ix;
}
constexpr int BG_TILES = 3 * 2048;
struct BgLane { unsigned sA, sB, dA, dB; };
__device__ __forceinline__ BgLane bg_lane(int tid) {
    const int wv = tid >> 6, lane = tid & 63, nl = (wv & 3) * 16 + (lane & 15), kl = (wv >> 2) * 32 + (lane >> 4) * 8;
    BgLane L;
    L.sA = (unsigned)(kl * 512 + nl); L.sB = (unsigned)(kl * 1024 + nl);
    L.dA = (unsigned)((128 * ((nl >> 2) & 1) + 32 * (nl >> 5) + 8 * ((nl >> 3) & 3) + (nl & 3)) * 1024 + kl);
    L.dB = (unsigned)(nl * 512 + kl);
    return L;
}
struct BgTile { const float* src; bf16_t* dst; unsigned so, d_o; int N; };
__device__ __forceinline__ BgTile bg_tile(const Params& p, int t, const BgLane& L) {
    t = t < BG_TILES ? t : BG_TILES - 1;
    const int mat = t >> 11, r = t & 2047, e = r >> 7, q = r & 127;
    bf16_t* w = (bf16_t*)(p.ws + OFF_WMOE);
    BgTile b;
    if (mat < 2) {
        const int kt = q >> 3, nt = q & 7;
        b.N = 512; b.src = (mat == 0 ? p.l1_w1 : p.l1_w3) + (size_t)e * (1024 * 512) + (size_t)(kt * 64) * 512 + nt * 64;
        b.dst = w + W_UP / 2 + (size_t)e * (1024 * 1024) + (size_t)(256 * (nt >> 1) + 64 * (nt & 1) + 4 * mat) * 1024 + kt * 64;
        b.so = L.sA; b.d_o = L.dA;
    } else {
        const int kt = q >> 4, nt = q & 15;
        b.N = 1024; b.src = p.l1_w2 + (size_t)e * (512 * 1024) + (size_t)(kt * 64) * 1024 + nt * 64;
        b.dst = w + W_DN / 2 + (size_t)e * (1024 * 512) + (size_t)(nt * 64) * 512 + kt * 64;
        b.so = L.sB; b.d_o = L.dB;
    }
    return b;
}
__device__ __forceinline__ void bg_load(const BgTile& b, float (&v)[8]) {
#pragma unroll
    for (int j = 0; j < 8; ++j) v[j] = b.src[b.so + (unsigned)(j * b.N)];
}
__device__ __forceinline__ void bg_store(const BgTile& b, const float (&v)[8]) {
    *(u32x4*)(b.dst + b.d_o) = (u32x4){pk2(v[0], v[1]), pk2(v[2], v[3]), pk2(v[4], v[5]), pk2(v[6], v[7])};
}
struct ScanPre { u32x4 v[2][4]; unsigned ok; float car; };
template <int PASS>
__device__ __forceinline__ void scan_prefetch(ScanPre& pre, const Params& p, const bf16_t* xr, int it, int tid) {
    const int blk = it & 7, cc = it >> 3, c = cc & (NCH - 1), b = cc >> 7, cq = tid & 15;
    const int row0 = b * S + c * LC, ch0 = blk * 128;
    unsigned okm = 0u;
#pragma unroll
    for (int i = 0; i < 2; ++i) {
        const int t = (tid >> 4) + 32 * i, sp = c * LC + t;
#pragma unroll
        for (int k = 0; k < 4; ++k) {
            const int ss = sp + k - 2; const bool ok = ss >= 0 && ss < S;
            const int rr = ok ? row0 + t + k - 2 : row0 + t;
            pre.v[i][k] = *(const u32x4*)(xr + (size_t)rr * 1024 + ch0 + cq * 8);
            okm |= (ok ? 1u : 0u) << (i * 4 + k);
        }
    }
    pre.ok = okm;
    if constexpr (PASS == 2) {
        const float* car = (const float*)(p.ws + OFF_RS + ((tid & 128) ? S_CARB : S_CARF));
        pre.car = car[(size_t)(b * NCH + c) * 1024 + ch0 + (tid & 127)];
    }
}
constexpr int REP_GEMM = 1, REP_SCAN = 1;
constexpr int SC_CONST = SC_GI + 65536;
template <int PASS>
__device__ __forceinline__ void phase_scan(const Params& p, char* lds) {
    const int tid = tidx(), lane = tid & 63, wid = tid >> 6, fr = lane & 15, fq = lane >> 4;
    const bf16_t* xr = (const bf16_t*)(p.ws + OFF_RS + S_XR);
    const bf16_t* gg = (const bf16_t*)(p.ws + OFF_RS + S_GG);
    const bf16_t* wg = (const bf16_t*)(p.ws + OFF_WS + W_GATE);
    float2* aggF = (float2*)(p.ws + OFF_RS + S_AGGF); float2* aggB = (float2*)(p.ws + OFF_RS + S_AGGB);
    bf16_t* yb = (bf16_t*)(p.ws + OFF_RS + S_XC);
    float* cst = (float*)(lds + SC_CONST);
    const int d = __builtin_amdgcn_readfirstlane(wid >> 2), q = __builtin_amdgcn_readfirstlane(wid & 3);
    bf16x8 wf[4][4];
    int cur_blk = -1;
    const int nitems = 2 * NCH * 8;
    ScanPre pre; pre.car = 0.f; pre.ok = 0u;
    int xsel = 0;
    const BgLane bgl = bg_lane(tid);
    for (int it = blockIdx.x; it < nitems; it += gridDim.x) {
        const int blk = it & 7, cc = it >> 3, c = cc & (NCH - 1), b = cc >> 7;
        const int row0 = b * S + c * LC, ch0 = blk * 128;
        char* xcb = lds + SC_XC + xsel * 16384; xsel ^= 1;
        if (blk != cur_blk) {
            cur_blk = blk;
#pragma unroll
            for (int n = 0; n < 4; ++n) {
                const bf16_t* wrow = wg + ((size_t)((2 * d + (n >> 1)) * 8 + blk) * 128 + q * 32 + (n & 1) * 16 + fr) * 128 + fq * 8;
#pragma unroll
                for (int kk = 0; kk < 4; ++kk) wf[n][kk] = *(const bf16x8*)(wrow + kk * 32);
            }
            {
                float cv[3];
#pragma unroll
                for (int k = 0; k < 3; ++k) {
                    const int i = tid + k * NTHR, j = __builtin_amdgcn_readfirstlane(i < 11 * 128 ? i >> 7 : 10);
                    const float* sp = j < 4 ? p.l1_conv_w + j * 1024 : j == 4 ? p.l1_conv_b : j == 5 ? p.l1_ba_f : j == 6 ? p.l1_bx_f : j == 7 ? p.l1_ba_b : j == 8 ? p.l1_bx_b : j == 9 ? p.l1_lam_f : p.l1_lam_b;
                    cv[k] = sp[ch0 + (i & 127)];
                }
#pragma unroll
                for (int k = 0; k < 3; ++k) {
                    const int i = tid + k * NTHR, j = i >> 7;
                    if (i < 11 * 128) cst[i] = j < 5 ? cv[k] : (j < 9 ? -LOG2E * cv[k] : lam_c(cv[k]) * LOG2E);
                }
            }
            scan_prefetch<PASS>(pre, p, xr, it, tid);
            __syncthreads();
        }
        float bgv[3][8];
        if constexpr (PASS == 1) {
            const int k3 = 3 * ((it - (int)blockIdx.x) / (int)gridDim.x);
#pragma unroll
            for (int j = 0; j < 3; ++j) { const BgTile bt = bg_tile(p, (k3 + j) * (int)gridDim.x + (int)blockIdx.x, bgl); bg_load(bt, bgv[j]); }
            __builtin_amdgcn_sched_barrier(0);
        }
        {
            const int cq = tid & 15;
            if (c == 0 || c == NCH - 1) {
#pragma unroll
                for (int i = 0; i < 2; ++i)
#pragma unroll
                    for (int k = 0; k < 4; ++k)
                        if (!((pre.ok >> (i * 4 + k)) & 1u)) pre.v[i][k] = (u32x4){0u, 0u, 0u, 0u};
            }
            f32x2 a[2][4];
            {
                const f32x4 b0 = *(const f32x4*)(cst + 4 * 128 + cq * 8), b1 = *(const f32x4*)(cst + 4 * 128 + cq * 8 + 4);
#pragma unroll
                for (int i = 0; i < 2; ++i) { a[i][0] = (f32x2){b0[0], b0[1]}; a[i][1] = (f32x2){b0[2], b0[3]}; a[i][2] = (f32x2){b1[0], b1[1]}; a[i][3] = (f32x2){b1[2], b1[3]}; }
            }
#pragma unroll
            for (int k = 0; k < 4; ++k) {
                const f32x4 w0 = *(const f32x4*)(cst + k * 128 + cq * 8), w1 = *(const f32x4*)(cst + k * 128 + cq * 8 + 4);
                const f32x2 wp0 = {w0[0], w0[1]}, wp1 = {w0[2], w0[3]}, wp2 = {w1[0], w1[1]}, wp3 = {w1[2], w1[3]};
#pragma unroll
                for (int i = 0; i < 2; ++i) {
                    const u32x4 v = pre.v[i][k];
                    a[i][0] = __builtin_elementwise_fma(wp0, (f32x2){__uint_as_float(v.x << 16), __uint_as_float(v.x & 0xffff0000u)}, a[i][0]);
                    a[i][1] = __builtin_elementwise_fma(wp1, (f32x2){__uint_as_float(v.y << 16), __uint_as_float(v.y & 0xffff0000u)}, a[i][1]);
                    a[i][2] = __builtin_elementwise_fma(wp2, (f32x2){__uint_as_float(v.z << 16), __uint_as_float(v.z & 0xffff0000u)}, a[i][2]);
                    a[i][3] = __builtin_elementwise_fma(wp3, (f32x2){__uint_as_float(v.w << 16), __uint_as_float(v.w & 0xffff0000u)}, a[i][3]);
                }
            }
#pragma unroll
            for (int i = 0; i < 2; ++i) {
                const int t = (tid >> 4) + 32 * i;
                u32x4 w; w.x = pkh(a[i][0].x, a[i][0].y); w.y = pkh(a[i][1].x, a[i][1].y); w.z = pkh(a[i][2].x, a[i][2].y); w.w = pkh(a[i][3].x, a[i][3].y);
                *(u32x4*)(xcb + t * 256 + ((cq ^ (t & 15)) << 4)) = w;
            }
        }
        const float hcar = pre.car;
        __syncthreads();
        if (it + (int)gridDim.x < nitems) scan_prefetch<PASS>(pre, p, xr, it + gridDim.x, tid);
        u32x2 ggv[4];
        if constexpr (PASS == 2) {
#pragma unroll
            for (int i = 0; i < 4; ++i) ggv[i] = *(const u32x2*)(gg + (size_t)(row0 + i * 16 + (tid >> 5)) * 1024 + ch0 + (tid & 31) * 4);
        }
        {
#pragma unroll 1
            for (int mhr = 0; mhr < 2 * (PASS == 1 ? REP_GEMM : 1); ++mhr) {
                const int mh = mhr & 1;
                f32x4 acc[2][4];
#pragma unroll
                for (int m = 0; m < 2; ++m)
#pragma unroll
                    for (int n = 0; n < 4; ++n) acc[m][n] = (f32x4){0.f, 0.f, 0.f, 0.f};
#pragma unroll
                for (int kk = 0; kk < 4; ++kk) {
                    bf16x8 xf[2];
#pragma unroll
                    for (int m = 0; m < 2; ++m) xf[m] = *(const bf16x8*)(xcb + ((mh * 2 + m) * 16 + fr) * 256 + (((kk * 4 + fq) ^ fr) << 4));
#pragma unroll
                    for (int m = 0; m < 2; ++m)
#pragma unroll
                        for (int n = 0; n < 4; ++n) acc[m][n] = MFMA16H(wf[n][kk], xf[m], acc[m][n]);
                }
#pragma unroll
                for (int pr = 0; pr < 2; ++pr) {
                    const int chl = q * 32 + pr * 16 + fq * 4;
                    const f32x4 bav = *(const f32x4*)(cst + (5 + 2 * d) * 128 + chl), bxv = *(const f32x4*)(cst + (6 + 2 * d) * 128 + chl), c8v = *(const f32x4*)(cst + (9 + d) * 128 + chl);
#pragma unroll
                    for (int m = 0; m < 2; ++m) {
                        u32x4 w;
#pragma unroll
                        for (int k2 = 0; k2 < 2; ++k2) {
                            const f32x2 NL = {-LOG2E, -LOG2E}, ONE = {1.f, 1.f};
                            const f32x2 ar = {acc[m][pr][2 * k2], acc[m][pr][2 * k2 + 1]}, ai = {acc[m][2 + pr][2 * k2], acc[m][2 + pr][2 * k2 + 1]};
                            const f32x2 nb = {bav[2 * k2], bav[2 * k2 + 1]}, nx = {bxv[2 * k2], bxv[2 * k2 + 1]}, c8 = {c8v[2 * k2], c8v[2 * k2 + 1]};
                            const f32x2 zr = __builtin_elementwise_fma(ar, NL, nb), zi = __builtin_elementwise_fma(ai, NL, nx);
                            const f32x2 d1 = (f32x2){__builtin_amdgcn_exp2f(zr.x), __builtin_amdgcn_exp2f(zr.y)} + ONE, d2 = (f32x2){__builtin_amdgcn_exp2f(zi.x), __builtin_amdgcn_exp2f(zi.y)} + ONE;
                            const f32x2 r = {__builtin_amdgcn_rcpf(d1.x), __builtin_amdgcn_rcpf(d1.y)}, ig = {__builtin_amdgcn_rcpf(d2.x), __builtin_amdgcn_rcpf(d2.y)};
                            const f32x2 x = c8 * r;
                            const f32x2 a = {__builtin_amdgcn_exp2f(x.x), __builtin_amdgcn_exp2f(x.y)};
                            const f32x2 om = ONE - a, t = __builtin_elementwise_fma(om, a, om);
                            const f32x2 g = (f32x2){__builtin_amdgcn_sqrtf(t.x), __builtin_amdgcn_sqrtf(t.y)} * ig;
                            w[2 * k2] = pkh(om.x, g.x); w[2 * k2 + 1] = pkh(om.y, g.y);
                        }
                        *(u32x4*)(lds + SC_GI + (d * 64 + (mh * 2 + m) * 16 + fr) * 512 + (((chl >> 2) ^ (fr & 7)) << 4)) = w;
                    }
                }
            }
        }
        __syncthreads();
        if constexpr (PASS == 1) {
          const int ch = q * 32 + (lane & 31), half = lane >> 5;
          const float c8 = cst[(9 + d) * 128 + ch];
#pragma unroll 1
          for (int rep = 0; rep < REP_SCAN; ++rep) {
            float A = 1.f, B = 0.f;
            const char* gbase = lds + SC_GI + (d * 64 + half * 32) * 512 + (ch & 3) * 4;
            const char* xbase = xcb + (half * 32) * 256 + (ch & 7) * 2;
#define SCAN1_STEP(UPD)                                                                                                   \
            _Pragma("unroll") for (int s = 0; s < 32; ++s) {                                                              \
                const unsigned v = *(const unsigned*)(gbase + s * 512 + (((ch >> 2) ^ (s & 7)) << 4));                     \
                const unsigned x = *(const unsigned short*)(xbase + s * 256 + (((ch >> 3) ^ (s & 15)) << 4));              \
                const float a = mix_a(v);                                                                                  \
                const float bb = mix_gx(v, x);                                                                             \
                UPD                                                                                                        \
            }
            if (d == 0) { SCAN1_STEP(B = a * B + bb; A *= a;) } else { SCAN1_STEP(B += A * bb; A *= a;) }
#undef SCAN1_STEP
            const float A1 = __shfl_xor(A, 32), B1 = __shfl_xor(B, 32);
            if (half == 0) {
                float At, Bt;
                if (d == 0) { At = A * A1; Bt = A1 * B + B1; } else { At = A * A1; Bt = B + A * B1; }
                (d == 0 ? aggF : aggB)[(size_t)(b * NCH + c) * 1024 + ch0 + ch] = make_float2(At, Bt);
            }
          }
          {
            __builtin_amdgcn_sched_barrier(0);
            const int k3 = 3 * ((it - (int)blockIdx.x) / (int)gridDim.x);
#pragma unroll
            for (int j = 0; j < 3; ++j) { const BgTile bt = bg_tile(p, (k3 + j) * (int)gridDim.x + (int)blockIdx.x, bgl); bg_store(bt, bgv[j]); }
          }
        } else {
            if (tid < 256) {
                const int dd = __builtin_amdgcn_readfirstlane(tid >> 7), ch = tid & 127;
                float h = hcar;
                char* gbase = lds + SC_GI + dd * 64 * 512 + (ch & 3) * 4;
                const char* xbase = xcb + (ch & 7) * 2;
#define SCAN2_GO(t) (gbase + (t) * 512 + (((ch >> 2) ^ ((t) & 7)) << 4))
#define SCAN2_XO(t) (xbase + (t) * 256 + (((ch >> 3) ^ ((t) & 15)) << 4))
#define SCAN2_DIR(TOF)                                                                                                        \
                {                                                                                                             \
                    unsigned v[2][8], x[2][8];                                                                          \
                    _Pragma("unroll") for (int j = 0; j < 8; ++j) { const int t = TOF(j); v[0][j] = *(const unsigned*)SCAN2_GO(t); x[0][j] = *(const unsigned short*)SCAN2_XO(t); } \
                    _Pragma("unroll") for (int sb = 0; sb < 8; ++sb) {                                                        \
                        if (sb < 7) {                                                                                         \
                            _Pragma("unroll") for (int j = 0; j < 8; ++j) { const int t = TOF((sb + 1) * 8 + j); v[(sb + 1) & 1][j] = *(const unsigned*)SCAN2_GO(t); x[(sb + 1) & 1][j] = *(const unsigned short*)SCAN2_XO(t); } \
                        }                                                                                                     \
                        float hh[8];                                                                                          \
                        _Pragma("unroll") for (int j = 0; j < 8; ++j) {                                                       \
                            h = __builtin_fmaf(mix_a(v[sb & 1][j]), h, mix_gx(v[sb & 1][j], x[sb & 1][j])); hh[j] = h;         \
                        }                                                                                                     \
                        _Pragma("unroll") for (int j = 0; j < 8; ++j) { const int t = TOF(sb * 8 + j); *(float*)SCAN2_GO(t) = hh[j]; } \
                    }                                                                                                         \
                }
#define SCAN2_FWD(s) (s)
#define SCAN2_BWD(s) (63 - (s))
                if (dd == 0) SCAN2_DIR(SCAN2_FWD) else SCAN2_DIR(SCAN2_BWD)
#undef SCAN2_DIR
#undef SCAN2_FWD
#undef SCAN2_BWD
#undef SCAN2_GO
#undef SCAN2_XO
            }
            __syncthreads();
#pragma unroll
            for (int i = 0; i < 4; ++i) {
                const int t = i * 16 + (tid >> 5), c4 = (tid & 31) * 4;
                const int so = t * 512 + (((tid & 31) ^ (t & 7)) << 4);
                const f32x4 hf = *(const f32x4*)(lds + SC_GI + so), hb = *(const f32x4*)(lds + SC_GI + 64 * 512 + so);
                const size_t go = (size_t)(row0 + t) * 1024 + ch0 + c4;
                const u32x2 g2 = ggv[i];
                f32x4 o;
                o[0] = (hf[0] + hb[0]) * __uint_as_float(g2.x << 16); o[1] = (hf[1] + hb[1]) * __uint_as_float(g2.x & 0xffff0000u);
                o[2] = (hf[2] + hb[2]) * __uint_as_float(g2.y << 16); o[3] = (hf[3] + hb[3]) * __uint_as_float(g2.y & 0xffff0000u);
                *(u32x2*)(yb + go) = pk4(o);
            }
        }
    }
}
__device__ __forceinline__ void phase_carry(const Params& p, char* lds) {
    const int tid = tidx(), seg = tid >> 6, chl = tid & 63;
    float2* sagg = (float2*)lds;
    for (int it = blockIdx.x; it < 64; it += gridDim.x) {
        const int dir = it >> 5, b = (it >> 4) & 1, ch = (it & 15) * 64 + chl;
        const float2* agg = (const float2*)(p.ws + OFF_RS + (dir == 0 ? S_AGGF : S_AGGB));
        float* car = (float*)(p.ws + OFF_RS + (dir == 0 ? S_CARF : S_CARB));
        float2 ab[16];
#pragma unroll
        for (int j = 0; j < 16; ++j) { const int w = seg * 16 + j, c = dir == 0 ? w : NCH - 1 - w; ab[j] = agg[(size_t)(b * NCH + c) * 1024 + ch]; }
        float A = 1.f, B = 0.f;
#pragma unroll
        for (int j = 0; j < 16; ++j) { B = ab[j].x * B + ab[j].y; A *= ab[j].x; }
        sagg[seg * 64 + chl] = make_float2(A, B);
        __syncthreads();
        float h = 0.f;
        for (int sg = 0; sg < seg; ++sg) { const float2 sa = sagg[sg * 64 + chl]; h = sa.x * h + sa.y; }
#pragma unroll
        for (int j = 0; j < 16; ++j) { const int w = seg * 16 + j, c = dir == 0 ? w : NCH - 1 - w; car[(size_t)(b * NCH + c) * 1024 + ch] = h; h = ab[j].x * h + ab[j].y; }
        __syncthreads();
    }
}

constexpr bool PG8_IN0 = true;
constexpr int NPTR = (int)(sizeof(Params) / 8);
struct KArgs { __attribute__((address_space(1))) char* a[NPTR]; };
typedef const __attribute__((address_space(4))) KArgs* KParams;
template <int PH> __device__ __forceinline__ void run_phase(KParams kp, char* lds) {
    asm volatile("" : "+s"(kp));
    Params p;
    {
        char** pp = (char**)&p;
#pragma unroll
        for (int i = 0; i < NPTR; ++i) pp[i] = (char*)kp->a[i];
    }
    bf16_t* ra = (bf16_t*)(p.ws + OFF_RA); float* rf = (float*)(p.ws + OFF_RF);
    if constexpr (PH == 0) phase_prologue(p, lds);
    else if constexpr (PH == 1) phase_prologue2(p, lds);
    else if constexpr (PH == 2) phase_in0(p, lds);
    else if constexpr (PH == 3) phase_up(p, lds);
    else if constexpr (PH == 4) phase_attn(p, lds);
    else if constexpr (PH == 5) phase_outproj(p, lds, (const bf16_t*)(p.ws + OFF_RS + S_CAT), (const bf16_t*)(p.ws + OFF_WS + W_OUT0), ra, (bf16_t*)p.out);
    else if constexpr (PH == 6) phase_ln_router(p, lds, (const bf16_t*)p.out, ra, p.l0_ln1_g, p.l0_ln1_b, 0);
    else if constexpr (PH == 7) phase_moe(p, lds, 0, 0);
    else if constexpr (PH == 8) phase_moe(p, lds, 0, 1);
    else if constexpr (PH == 9) phase_ln2(p, ra, nullptr, ra, p.l0_ln2_g, p.l0_ln2_b);
    else if constexpr (PH == 10) phase_in1(p, lds);
    else if constexpr (PH == 11) phase_scan<1>(p, lds);
    else if constexpr (PH == 12) phase_carry(p, lds);
    else if constexpr (PH == 13) phase_scan<2>(p, lds);
    else if constexpr (PH == 14) phase_outproj(p, lds, (const bf16_t*)(p.ws + OFF_RS + S_XC), (const bf16_t*)(p.ws + OFF_WS + W_OUT1), ra, (bf16_t*)p.out);
    else if constexpr (PH == 15) {
        if (3 * ((2 * NCH * 8) / (int)gridDim.x) * (int)gridDim.x < BG_TILES || (2 * NCH * 8) % (int)gridDim.x != 0)
            for (int id = blockIdx.x; id < 3 * TC_MOE; id += gridDim.x) conv_moe(p, lds, id, 1);
        __syncthreads();
        phase_ln_router(p, lds, (const bf16_t*)p.out, ra, p.l1_ln1_g, p.l1_ln1_b, 1);
    }
    else if constexpr (PH == 16) phase_moe(p, lds, 1, 0);
    else if constexpr (PH == 17) phase_moe(p, lds, 1, 1);
    else if constexpr (PH == 18) phase_ln2(p, ra, p.out, nullptr, p.l1_ln2_g, p.l1_ln2_b);
}

#define XB_TMO      128
#define XB_XCNT(j)  (256  + 64 * (j))
#define XB_XSUB(j)  (1280 + 64 * (j))
#define XB_XGEN(j)  (2304 + 64 * (j))
#define XB_TOP      3328
#define XB_TOPGEN   3392
#define XCD_BAR_WORDS 3456
#define XB_SPIN_CAP (1u << 20)
__device__ __forceinline__ unsigned xb_ld(unsigned* p)              { return __hip_atomic_load(p, __ATOMIC_RELAXED, __HIP_MEMORY_SCOPE_AGENT); }
__device__ __forceinline__ unsigned xb_add(unsigned* p, unsigned v) { return __hip_atomic_fetch_add(p, v, __ATOMIC_RELAXED, __HIP_MEMORY_SCOPE_AGENT); }
__device__ __forceinline__ unsigned xb_xcc_id() { return (unsigned)__builtin_amdgcn_s_getreg((3 << 11) | 20) & 0xFu; }
#define XB_SPIN(cond, bar) do { unsigned _sp = 0; while (cond) { __builtin_amdgcn_s_sleep(1); \
    if ((++_sp & 255u) == 0u) { if (xb_ld(&(bar)[XB_TMO])) break; if (_sp > XB_SPIN_CAP) { atomicAdd(&(bar)[XB_TMO], 1u); break; } } } } while (0)
struct XcdBarrier { unsigned* bar; unsigned x; volatile LAS unsigned* st; };
__device__ __forceinline__ XcdBarrier xcd_barrier_post(unsigned* bar, volatile LAS unsigned* st) {
    XcdBarrier b; b.bar = bar; b.x = xb_xcc_id(); b.st = st;
    if (threadIdx.x == 0) (void)xb_add(&bar[XB_XCNT(b.x)], 1u);
    return b;
}
__device__ __forceinline__ void xcd_barrier_complete(unsigned* bar, unsigned x, unsigned& nloc, unsigned& nx) {
    const unsigned G = gridDim.x * gridDim.y * gridDim.z;
    unsigned sum, cnt, mine, sp = 0u;
    for (;;) {
        sum = 0u; cnt = 0u; mine = 0u;
#pragma unroll
        for (unsigned j = 0; j < 16; ++j) { const unsigned c = xb_ld(&bar[XB_XCNT(j)]); sum += c; cnt += (c > 0u) ? 1u : 0u; mine = (j == x) ? c : mine; }
        if (sum == G) break;
        __builtin_amdgcn_s_sleep(1);
        if ((++sp & 255u) == 0u) { if (xb_ld(&bar[XB_TMO])) break; if (sp > XB_SPIN_CAP) { atomicAdd(&bar[XB_TMO], 1u); break; } }
    }
    nloc = mine > 0u ? mine : 1u; nx = cnt > 0u ? cnt : 1u;
}
__device__ __forceinline__ void xcd_barrier(const XcdBarrier& b) {
    asm volatile("s_waitcnt vmcnt(0)" ::: "memory");
    __syncthreads();
    if (threadIdx.x == 0) {
        unsigned* bar = b.bar;
        __builtin_amdgcn_s_waitcnt(0);
        unsigned nloc = b.st[0], nx = b.st[1];
        if (nloc == 0u) { xcd_barrier_complete(bar, b.x, nloc, nx); b.st[0] = nloc; b.st[1] = nx; }
        const unsigned old = xb_add(&bar[XB_XSUB(b.x)], 1u);
        const unsigned gen = old / nloc;
        if (old + 1u == (gen + 1u) * nloc) {
            __builtin_amdgcn_fence(__ATOMIC_RELEASE, "agent");
            asm volatile("s_waitcnt vmcnt(0)" ::: "memory");
            const unsigned og = xb_add(&bar[XB_TOP], 1u);
            if (og + 1u == (og / nx + 1u) * nx) {
#pragma unroll
                for (unsigned j = 0; j < 16; ++j) __hip_atomic_fetch_add(&bar[XB_XGEN(j)], 1u, __ATOMIC_RELAXED, __HIP_MEMORY_SCOPE_AGENT);
            } else XB_SPIN(xb_ld(&bar[XB_XGEN(b.x)]) == gen, bar);
            __builtin_amdgcn_fence(__ATOMIC_ACQUIRE, "agent");
            asm volatile("s_waitcnt vmcnt(0)" ::: "memory");
        } else {
            XB_SPIN(xb_ld(&bar[XB_XGEN(b.x)]) == gen, bar);
            __builtin_amdgcn_fence(__ATOMIC_ACQUIRE, "agent");
            asm volatile("s_waitcnt vmcnt(0)" ::: "memory");
        }
    }
    __syncthreads();
}

constexpr unsigned NOBAR_MASK = 0u;
constexpr unsigned DUP_MASK = 0u;
template <int PH, int END> struct RunAll {
    static __device__ __forceinline__ void go(KParams kp, char* lds, const XcdBarrier& xb) {
        run_phase<PH>(kp, lds);
        if constexpr ((DUP_MASK >> PH) & 1u) { __syncthreads(); run_phase<PH>(kp, lds); }
        if constexpr (PH + 1 < END) { if constexpr (!((NOBAR_MASK >> PH) & 1u)) xcd_barrier(xb); RunAll<PH + 1, END>::go(kp, lds, xb); }
    }
};
__global__ void __launch_bounds__(NTHR) mega_kernel(KArgs ka) {
    extern __shared__ __attribute__((aligned(16))) char lds[];
    volatile LAS unsigned* st = (volatile LAS unsigned*)(LAS char*)(lds + LDS_BYTES);
    if (threadIdx.x == 0) { st[0] = 0u; st[1] = 0u; }
    __syncthreads();
    const XcdBarrier xb = xcd_barrier_post((unsigned*)((char*)ka.a[NPTR - 1] + OFF_MISC + M_BAR), st);
    RunAll<0, 19>::go((KParams)__builtin_amdgcn_kernarg_segment_ptr(), lds, xb);
}
}

extern "C" void kernel_launch(void* const* d_in, const int* in_sizes, int n_in, void* d_out, int out_size, void* d_ws, size_t ws_size, hipStream_t stream) {
    Params p{};
    const float** f = (const float**)&p;
    for (int i = 0; i < 39; ++i) f[i] = (const float*)d_in[i];
    p.out = (float*)d_out; p.ws = (char*)d_ws;
    if (ws_size < WS_NEED) fprintf(stderr, "workspace too small: %zu < %zu\n", ws_size, (size_t)WS_NEED);
    (void)hipMemsetAsync(p.ws + OFF_MISC, 0, 32768, stream);
    static int grid_blocks = 0;
    if (!grid_blocks) {
        (void)hipFuncSetAttribute((const void*)mega_kernel, hipFuncAttributeMaxDynamicSharedMemorySize, LDS_TOTAL);
        int dev = 0, cus = 0, per_cu = 0;
        (void)hipGetDevice(&dev);
        (void)hipDeviceGetAttribute(&cus, hipDeviceAttributeMultiprocessorCount, dev);
        (void)hipOccupancyMaxActiveBlocksPerMultiprocessor(&per_cu, mega_kernel, NTHR, LDS_TOTAL);
        if (per_cu > 1) per_cu = 1;
        grid_blocks = cus * per_cu;
        if (grid_blocks <= 0) { fprintf(stderr, "occupancy query failed: cus %d per_cu %d\n", cus, per_cu); grid_blocks = 256; }
    }
    void* args[] = {&p};
    hipError_t e = hipLaunchCooperativeKernel((const void*)mega_kernel, dim3(grid_blocks), dim3(NTHR), args, LDS_TOTAL, stream);
    if (e != hipSuccess) fprintf(stderr, "cooperative launch failed: %s (grid %d)\n", hipGetErrorString(e), grid_blocks);
}
```

```cpp
#include <hip/hip_runtime.h>
#include <hip/hip_cooperative_groups.h>
#include <stdint.h>
#include <stdio.h>

namespace {
typedef unsigned short bf16_t;
typedef short bf16x8 __attribute__((ext_vector_type(8)));
typedef short s16x4 __attribute__((ext_vector_type(4)));
typedef float f32x4 __attribute__((ext_vector_type(4)));
typedef float f32x2 __attribute__((ext_vector_type(2)));
typedef float f32x16 __attribute__((ext_vector_type(16)));
typedef unsigned u32x2 __attribute__((ext_vector_type(2)));
typedef unsigned u32x4 __attribute__((ext_vector_type(4)));
#define LAS __attribute__((address_space(3)))

constexpr int T = 16384, S = 8192, D = 1024;
constexpr int NTHR = 512;
constexpr size_t MiB = (size_t)1 << 20;
constexpr float LOG2E = 1.4426950408889634f;
constexpr float ALPHA = 1.4142135623730951f;
constexpr float LN_EPS = 1e-5f, RMS_EPS = 1e-6f;
constexpr float QSCALE_MLA = 0.10206207261596575f * LOG2E;
constexpr float QSCALE_SWA = 0.125f * LOG2E;

constexpr size_t OFF_MISC = 0;
constexpr size_t OFF_WS   = 4 * MiB;
constexpr size_t OFF_WMOE = 17 * MiB;
constexpr size_t OFF_RA   = 65 * MiB;
constexpr size_t OFF_RF   = 97 * MiB;
constexpr size_t OFF_RS   = 161 * MiB;
constexpr size_t WS_NEED  = 279 * MiB;
constexpr size_t M_CNT   = 0;
constexpr size_t M_BAR   = 4096;
constexpr size_t M_BIAS  = 64 * 1024;
constexpr size_t M_SSQQ  = 128 * 1024;
constexpr size_t M_SSQKV = 640 * 1024;
constexpr size_t M_GATEW = 896 * 1024;
constexpr size_t M_ROPE  = 1 * MiB;
constexpr size_t M_LIST  = 2 * MiB;
constexpr size_t W_IN0  = 0;
constexpr size_t W_UQ   = 2560 * 1024;
constexpr size_t W_UKV  = W_UQ + 768 * 256 * 2;
constexpr size_t W_OUT0 = W_UKV + 1024 * 256 * 2;
constexpr size_t W_IN1  = W_OUT0 + 2 * MiB;
constexpr size_t W_GATE = W_IN1 + 4 * MiB;
constexpr size_t W_OUT1 = W_GATE + 1 * MiB;
constexpr size_t W_UP = 0;
constexpr size_t W_DN = 32 * MiB;
constexpr size_t S_QLAT = 0, S_KVLAT = 8 * MiB  , S_QB = 16 * MiB, S_KB = 32 * MiB, S_VB = 36 * MiB, S_V = 40 * MiB, S_CAT = 56 * MiB;
constexpr size_t S_HMOE = 0, S_Y = 32 * MiB;
constexpr size_t S_GG = 0, S_XR = 32 * MiB, S_XC = 64 * MiB, S_AGGF = 96 * MiB, S_AGGB = 100 * MiB, S_CARF = 104 * MiB, S_CARB = 106 * MiB;

struct Params {
    const float *x, *rel_bias, *router_w, *router_bias;
    const float *l0_w_in, *l0_q_norm, *l0_w_uq, *l0_kv_norm, *l0_w_ukv, *l0_sinks, *l0_w_out, *l0_ln1_g, *l0_ln1_b, *l0_w1, *l0_w3, *l0_w2, *l0_ln2_g, *l0_ln2_b;
    const float *l1_w_in, *l1_conv_w, *l1_conv_b, *l1_wa_f, *l1_ba_f, *l1_wx_f, *l1_bx_f, *l1_lam_f, *l1_wa_b, *l1_ba_b, *l1_wx_b, *l1_bx_b, *l1_lam_b, *l1_w_out,
                *l1_ln1_g, *l1_ln1_b, *l1_w1, *l1_w3, *l1_w2, *l1_ln2_g, *l1_ln2_b;
    float* out;
    char* ws;
};

__device__ __forceinline__ float bf2f(bf16_t v) { return __uint_as_float((unsigned)v << 16); }
__device__ __forceinline__ bf16_t f2bf(float f) { unsigned u = __float_as_uint(f); u += 0x7fffu + ((u >> 16) & 1u); return (bf16_t)(u >> 16); }
__device__ __forceinline__ unsigned pk2(float lo, float hi) { unsigned r; asm("v_cvt_pk_bf16_f32 %0, %1, %2" : "=v"(r) : "v"(lo), "v"(hi)); return r; }
__device__ __forceinline__ u32x2 pk4(f32x4 v) { u32x2 r; r.x = pk2(v[0], v[1]); r.y = pk2(v[2], v[3]); return r; }
__device__ __forceinline__ float sigmoidf_(float x) { return 1.0f / (1.0f + __expf(-x)); }
__device__ __forceinline__ float fsigmoid(float x) { return __builtin_amdgcn_rcpf(1.0f + __builtin_amdgcn_exp2f(-LOG2E * x)); }
__device__ __forceinline__ float wave_sum(float v) {
#pragma unroll
    for (int o = 32; o >= 1; o >>= 1) v += __shfl_xor(v, o);
    return v;
}
__device__ __forceinline__ int crow(int r, int hi) { return (r & 3) + 8 * (r >> 2) + 4 * hi; }
#define MFMA16(a, b, c) __builtin_amdgcn_mfma_f32_16x16x32_bf16(a, b, c, 0, 0, 0)
#define MFMA32(a, b, c) __builtin_amdgcn_mfma_f32_32x32x16_bf16(a, b, c, 0, 0, 0)
typedef _Float16 f16x8 __attribute__((ext_vector_type(8)));
#define MFMA16H(a, b, c) __builtin_amdgcn_mfma_f32_16x16x32_f16(__builtin_bit_cast(f16x8, a), __builtin_bit_cast(f16x8, b), c, 0, 0, 0)
__device__ __forceinline__ unsigned pkh(float lo, float hi) { unsigned r; asm("v_cvt_pk_f16_f32 %0, %1, %2" : "=v"(r) : "v"(lo), "v"(hi)); return r; }
__device__ __forceinline__ float mix_a(unsigned v) { float a; asm("v_fma_mix_f32 %0, -%1, 1.0, 1.0 op_sel_hi:[1,0,0]" : "=v"(a) : "v"(v)); return a; }
__device__ __forceinline__ float mix_gx(unsigned v, unsigned x) { float b; asm("v_fma_mix_f32 %0, %1, %2, 0 op_sel:[1,0,0] op_sel_hi:[1,1,0]" : "=v"(b) : "v"(v), "v"(x)); return b; }

__device__ __forceinline__ float gelu_tanh(float x) {
    const float u = 0.7978845608028654f * (x + 0.044715f * x * x * x);
    const float t = 1.0f - 2.0f * __builtin_amdgcn_rcpf(1.0f + __builtin_amdgcn_exp2f(2.0f * LOG2E * u));
    return 0.5f * x * (1.0f + t);
}
__device__ __forceinline__ int tidx() { int t = threadIdx.x; asm volatile("" : "+v"(t)); return t; }

constexpr int G_A_BYTES = 256 * 128, G_B_BYTES = 128 * 128, G_STAGE = G_A_BYTES + G_B_BYTES;
constexpr int LDS_BYTES = 131072, LDS_MTAB = LDS_BYTES + 16  , LDS_TOTAL = LDS_MTAB + 160 * 8 + 256;

struct ARows { const bf16_t* p[4]; };

template <class Epi>
__device__ __forceinline__ void gemm_tile(char* lds, const ARows& ar, const bf16_t* Bt, int ldb, int K, const Epi& epi) {
    const int tid = tidx(), lane = tid & 63, wid = tid >> 6, wm = wid >> 1, wn = wid & 1, fr = lane & 15, fq = lane >> 4;
    const int srow = tid >> 3, skc = tid & 7;
    const int st_off = srow * 128 + ((skc ^ (srow & 7)) << 4);
    const bf16_t* bp0 = Bt + (size_t)srow * ldb + skc * 8;
    const bf16_t* bp1 = Bt + (size_t)(srow + 64) * ldb + skc * 8;
    const int kofs = skc * 8;
    f32x4 acc[4][4];
#pragma unroll
    for (int m = 0; m < 4; ++m)
#pragma unroll
        for (int n = 0; n < 4; ++n) acc[m][n] = (f32x4){0.f, 0.f, 0.f, 0.f};
    u32x4 ra[4], rb[2];
    const int nk = K >> 6;
#pragma unroll
    for (int i = 0; i < 4; ++i) ra[i] = *(const u32x4*)(ar.p[i] + kofs);
    rb[0] = *(const u32x4*)bp0; rb[1] = *(const u32x4*)bp1;
#pragma unroll
    for (int i = 0; i < 4; ++i) *(u32x4*)(lds + st_off + i * 8192) = ra[i];
    *(u32x4*)(lds + G_A_BYTES + st_off) = rb[0]; *(u32x4*)(lds + G_A_BYTES + st_off + 8192) = rb[1];
    __syncthreads();
    const int fa = (wm * 64 + fr) * 128, fb = G_A_BYTES + (wn * 64 + fr) * 128;
    const int c0 = ((fq ^ (fr & 7)) << 4), c1 = (((4 + fq) ^ (fr & 7)) << 4);
#pragma unroll 1
    for (int kt = 0; kt < nk; ++kt) {
        char* cur = lds + (kt & 1) * G_STAGE;
        char* nxt = lds + ((kt + 1) & 1) * G_STAGE;
        const bool more = (kt + 1 < nk);
        if (more) {
            const int ko = (kt + 1) * 64;
#pragma unroll
            for (int i = 0; i < 4; ++i) ra[i] = *(const u32x4*)(ar.p[i] + ko + kofs);
            rb[0] = *(const u32x4*)(bp0 + ko); rb[1] = *(const u32x4*)(bp1 + ko);
        }
#pragma unroll
        for (int kk = 0; kk < 2; ++kk) {
            const int cc = kk ? c1 : c0;
            bf16x8 af[4], bfr[4];
#pragma unroll
            for (int m = 0; m < 4; ++m) af[m] = *(const bf16x8*)(cur + fa + m * 2048 + cc);
#pragma unroll
            for (int n = 0; n < 4; ++n) bfr[n] = *(const bf16x8*)(cur + fb + n * 2048 + cc);
#pragma unroll
            for (int m = 0; m < 4; ++m)
#pragma unroll
                for (int n = 0; n < 4; ++n) acc[m][n] = MFMA16(bfr[n], af[m], acc[m][n]);
        }
        if (more) {
#pragma unroll
            for (int i = 0; i < 4; ++i) *(u32x4*)(nxt + st_off + i * 8192) = ra[i];
            *(u32x4*)(nxt + G_A_BYTES + st_off) = rb[0]; *(u32x4*)(nxt + G_A_BYTES + st_off + 8192) = rb[1];
        }
        __syncthreads();
    }
    epi(acc, wm, wn, fr, fq);
}

namespace pg8 {
constexpr int BM = 256, BK = 64, HALF = 128, HTB = HALF * BK * 2, STAGE_BYTES = 8 * HTB, NXCD = 8, WGM = 8;
__device__ __forceinline__ int lds_byte(int r, int c) { const int st = (r >> 4) * 2 + (c >> 5), rr = r & 15, cc = c & 31, ob = rr * 64 + cc * 2; return st * 1024 + (ob ^ (((ob >> 9) & 1) << 5)); }
__device__ __forceinline__ void stage_rc(int b, int& R, int& C) { const int st = b / 1024, sb = b % 1024, swz = sb ^ (((sb >> 9) & 1) << 5); R = (st >> 1) * 16 + swz / 64; C = (st & 1) * 32 + (swz % 64) / 2; }
__device__ __forceinline__ int perm32(int rho) { const int n = rho >> 4, i = rho & 15; return 8 * (i >> 2) + 4 * n + (i & 3); }
struct Unit { int pm, pn, e, valid; const int* lst; };
struct StaticOrder {
    int nM, nN, nwg, G, c;
    __device__ void init(int M, int N, int G_, int c_) { nM = M / BM; nN = N / BM; nwg = nM * nN; G = G_; c = c_; }
    __device__ bool next(int i, Unit& u) const {
        const long L = (long)i * G + c; if (L >= nwg) return false;
        int wgid = (int)L; { const int q = nwg / NXCD, r = nwg % NXCD, xcd = wgid % NXCD, off = wgid / NXCD; wgid = (xcd < r ? xcd * (q + 1) : r * (q + 1) + (xcd - r) * q) + off; }
        const int nig = WGM * nN, gid = wgid / nig, fm = gid * WGM, gsz = (nM - fm) < WGM ? (nM - fm) : WGM;
        u.pm = fm + ((wgid % nig) % gsz); u.pn = (wgid % nig) / gsz; u.e = 0; u.valid = 256; u.lst = nullptr; return true;
    }
};
struct DenseRows { __device__ __forceinline__ unsigned rowoff(const Unit& u, int row, int K) const { return (unsigned)(u.pm * BM + row) * (unsigned)K * 2u; } };

#define PG8_LAS __attribute__((address_space(3)))
template <bool HOOKS = false, class Epi, class Sched, class ARowSrc>
__device__ __forceinline__ void gemm_phase(char* lds_generic, const bf16_t* Abase, const bf16_t* Btbase, int K, const Sched& S, const ARowSrc& AR, const Epi& E) {
    PG8_LAS unsigned char* lds = (PG8_LAS unsigned char*)lds_generic;
    const int tid = tidx(), wid = __builtin_amdgcn_readfirstlane(tid >> 6), lane = tid & 63, wr = wid >> 2, wc = wid & 3, fr = lane & 15, fq = lane >> 4;
    const int nt = K / BK;
    int sR[2], sC[2]; unsigned voffB[2];
#pragma unroll
    for (int i = 0; i < 2; ++i) { stage_rc(tid * 16 + i * 8192, sR[i], sC[i]); const int Rb = Epi::PERM ? ((sR[i] & ~31) + perm32(sR[i] & 31)) : sR[i]; voffB[i] = (unsigned)(Rb * K + sC[i]) * 2u; }
    const size_t kstep = (size_t)(BK * 2);
    const size_t hstep = (size_t)HALF * K * 2;
    const size_t tstep = 2 * hstep;
    const unsigned ldsw = (unsigned)wid * 1024u;
    const int aoff = lds_byte(wr * 64 + fr, fq * 8), boff = lds_byte(wc * 32 + fr, fq * 8);
#define PG8_SA(b, h) (((b) * 2 + (h)) * HTB)
#define PG8_SB(b, h) ((4 + (b) * 2 + (h)) * HTB)
#define PG8_GLDS(src, dstoff) do { __builtin_amdgcn_global_load_lds((const __attribute__((address_space(1))) unsigned*)(src), (PG8_LAS unsigned*)(lds + (dstoff)), 16, 0, 0); asm volatile("" ::: "memory"); } while (0)
#define PG8_STAGE_B(bufoff, gbase) do { _Pragma("unroll") for (int _i = 0; _i < 2; ++_i) PG8_GLDS((const char*)(gbase) + voffB[_i], (bufoff) + ldsw + _i * 8192); } while (0)
#define PG8_STAGE_A(bufoff, AO, h, kb) do { _Pragma("unroll") for (int _i = 0; _i < 2; ++_i) PG8_GLDS((const char*)Abase + (AO)[h][_i] + (kb), (bufoff) + ldsw + _i * 8192); } while (0)
#define PG8_LDA(dst, b, h) do { _Pragma("unroll") for (int m = 0; m < 4; ++m) _Pragma("unroll") for (int k = 0; k < 2; ++k) dst[m][k] = *(const PG8_LAS bf16x8*)(lds + PG8_SA(b, h) + aoff + m * 2048 + k * 1024); } while (0)
#define PG8_LDB(dst, b, h) do { _Pragma("unroll") for (int n = 0; n < 2; ++n) _Pragma("unroll") for (int k = 0; k < 2; ++k) dst[n][k] = *(const PG8_LAS bf16x8*)(lds + PG8_SB(b, h) + boff + n * 2048 + k * 1024); } while (0)
#define PG8_MMA(ai, bj, At, Bt) do { __builtin_amdgcn_s_setprio(1); _Pragma("unroll") for (int m = 0; m < 4; ++m) _Pragma("unroll") for (int n = 0; n < 2; ++n) _Pragma("unroll") for (int k = 0; k < 2; ++k) \
        acc[ai][bj][m][n] = __builtin_amdgcn_mfma_f32_16x16x32_bf16(Bt[n][k], At[m][k], acc[ai][bj][m][n], 0, 0, 0); __builtin_amdgcn_s_setprio(0); } while (0)
#define PG8_WAIT_V(n) asm volatile("s_waitcnt vmcnt(" #n ")" ::: "memory")
#define PG8_WAIT_L(n) asm volatile("s_waitcnt lgkmcnt(" #n ")" ::: "memory")
#define PG8_BAR __builtin_amdgcn_s_barrier()
#define PG8_SCHED __builtin_amdgcn_sched_barrier(0)
    Unit cur, nxt; int ui = 0;
    if (!S.next(0, cur)) return;
    if constexpr (HOOKS) S.a_ready(cur);
    f32x4 acc[2][2][4][2];
#pragma unroll
    for (int a = 0; a < 2; ++a)
#pragma unroll
        for (int b = 0; b < 2; ++b)
#pragma unroll
            for (int m = 0; m < 4; ++m)
#pragma unroll
                for (int n = 0; n < 2; ++n) acc[a][b][m][n] = (f32x4){0.f, 0.f, 0.f, 0.f};
    bf16x8 At[4][2], B0[2][2], B1[2][2];
    unsigned aoC[2][2], aoN[2][2];
#pragma unroll
    for (int h = 0; h < 2; ++h)
#pragma unroll
        for (int i = 0; i < 2; ++i) aoC[h][i] = AR.rowoff(cur, h * HALF + sR[i], K) + (unsigned)sC[i] * 2u;
    const char* cB = (const char*)Btbase + (size_t)cur.pn * tstep;
    PG8_STAGE_B(PG8_SB(0, 0), cB); PG8_STAGE_B(PG8_SB(0, 1), cB + hstep); PG8_STAGE_A(PG8_SA(0, 0), aoC, 0, 0); PG8_STAGE_A(PG8_SA(0, 1), aoC, 1, 0);
    if (wr == 1) PG8_BAR;
    PG8_WAIT_V(2); PG8_BAR;
    PG8_STAGE_B(PG8_SB(1, 0), cB + kstep); PG8_STAGE_A(PG8_SA(1, 0), aoC, 0, kstep); PG8_STAGE_B(PG8_SB(1, 1), cB + hstep + kstep);
    PG8_WAIT_V(6); PG8_BAR;
    for (;;) {
        const bool has_next = S.next(ui + 1, nxt);
#pragma unroll
        for (int h = 0; h < 2; ++h)
#pragma unroll
            for (int i = 0; i < 2; ++i) aoN[h][i] = AR.rowoff(has_next ? nxt : cur, h * HALF + sR[i], K) + (unsigned)sC[i] * 2u;
        const char* nB = has_next ? (const char*)Btbase + (size_t)nxt.pn * tstep : cB;
#pragma unroll 1
        for (int t = 0; t < nt; t += 2) {
            const bool last = (t == nt - 2);
            if constexpr (HOOKS) { if (last && has_next) S.a_ready(nxt); }
            const unsigned k1 = (unsigned)(t + 1) * (unsigned)kstep;
            const unsigned k2 = last ? 0u : (unsigned)(t + 2) * (unsigned)kstep, k3 = k2 + (unsigned)kstep;
            unsigned ao2[2][2];
#pragma unroll
            for (int h = 0; h < 2; ++h)
#pragma unroll
                for (int i = 0; i < 2; ++i) ao2[h][i] = last ? aoN[h][i] : aoC[h][i];
            const char* b2 = last ? nB : cB + (size_t)(t + 2) * kstep; const char* b3 = b2 + kstep;
            PG8_LDB(B0, 0, 0); PG8_LDB(B1, 0, 1); PG8_SCHED; PG8_LDA(At, 0, 0); PG8_STAGE_A(PG8_SA(1, 1), aoC, 1, k1);
            PG8_WAIT_V(8); PG8_WAIT_L(0); PG8_BAR; PG8_MMA(0, 0, At, B0); PG8_MMA(0, 1, At, B1); PG8_BAR; PG8_SCHED;
            PG8_LDA(At, 0, 1); PG8_STAGE_B(PG8_SB(0, 0), b2); PG8_STAGE_B(PG8_SB(0, 1), b2 + hstep); PG8_STAGE_A(PG8_SA(0, 0), ao2, 0, k2);
            PG8_WAIT_V(8); PG8_WAIT_L(0); PG8_BAR; PG8_MMA(1, 0, At, B0); PG8_MMA(1, 1, At, B1); PG8_BAR; PG8_SCHED;
            PG8_LDB(B0, 1, 0); PG8_LDB(B1, 1, 1); PG8_SCHED; PG8_LDA(At, 1, 0); PG8_STAGE_A(PG8_SA(0, 1), ao2, 1, k2);
            PG8_WAIT_V(8); PG8_WAIT_L(0); PG8_BAR; PG8_MMA(0, 0, At, B0); PG8_MMA(0, 1, At, B1); PG8_BAR; PG8_SCHED;
            PG8_LDA(At, 1, 1); PG8_STAGE_B(PG8_SB(1, 0), b3); PG8_STAGE_B(PG8_SB(1, 1), b3 + hstep); PG8_STAGE_A(PG8_SA(1, 0), ao2, 0, k3);
            PG8_WAIT_V(8); PG8_WAIT_L(0); PG8_BAR; PG8_MMA(1, 0, At, B0); PG8_MMA(1, 1, At, B1); PG8_BAR; PG8_SCHED;
        }
        if (wr == 0) PG8_BAR;
        E(acc, cur, wr, wc, fr, fq);
        if constexpr (HOOKS) S.done(cur);
        if (!has_next) break;
#pragma unroll
        for (int a = 0; a < 2; ++a)
#pragma unroll
            for (int b = 0; b < 2; ++b)
#pragma unroll
                for (int m = 0; m < 4; ++m)
#pragma unroll
                    for (int n = 0; n < 2; ++n) acc[a][b][m][n] = (f32x4){0.f, 0.f, 0.f, 0.f};
        cur = nxt; cB = nB; ++ui;
#pragma unroll
        for (int h = 0; h < 2; ++h)
#pragma unroll
            for (int i = 0; i < 2; ++i) aoC[h][i] = aoN[h][i];
        if (wr == 1) PG8_BAR;
    }
    PG8_WAIT_V(0);
    PG8_BAR;
#undef PG8_SA
#undef PG8_SB
#undef PG8_GLDS
#undef PG8_STAGE_A
#undef PG8_STAGE_B
#undef PG8_LDA
#undef PG8_LDB
#undef PG8_MMA
#undef PG8_WAIT_V
#undef PG8_WAIT_L
#undef PG8_BAR
#undef PG8_SCHED
}
}

__device__ __forceinline__ ARows plain_rows(const bf16_t* A, int lda, int m0) {
    ARows r; const int srow = tidx() >> 3;
#pragma unroll
    for (int i = 0; i < 4; ++i) r.p[i] = A + (size_t)(m0 + srow + 64 * i) * lda;
    return r;
}

__device__ __forceinline__ int nmap(int mode, int n) {
    switch (mode) {
        case 1: { if (n < 384) return n; if (n >= 416) return n - 416 + 384; const int i = (n - 384) & 15, hf = (n - 384) >> 4; return 1152 + (i >> 2) * 8 + hf * 4 + (i & 3); }
        case 2: { const int h = n / 96, d = n - h * 96; if (d < 64) return h * 64 + d; const int i = (d - 64) & 15, hf = (d - 64) >> 4; return 512 + h * 32 + (i >> 2) * 8 + hf * 4 + (i & 3); }
        case 3: return 256 * (n >> 7) + 128 * ((n >> 2) & 1) + 32 * ((n >> 5) & 3) + 8 * ((n >> 3) & 3) + (n & 3);
        case 4: return 256 * (n >> 7) + 128 * ((n >> 2) & 1) + 32 * ((n >> 5) & 3) + 8 * ((n >> 3) & 3) + 4 + (n & 3);
        default: return n;
    }
}
__device__ __forceinline__ void tconv_tile(char* lds, const float* src, int lds_src, int N, bf16_t* dst, int ldd, int k0, int n0, int mode, const float* ks) {
    float* t = (float*)lds;
    const int tid = tidx();
    {
        const int nl = (tid & 15) * 4, n = n0 + nl, nc = n < N ? n : 0;
        f32x4 v[2]; float sc[2] = {1.f, 1.f};
#pragma unroll
        for (int i = 0; i < 2; ++i) v[i] = *(const f32x4*)(src + (size_t)(k0 + (tid >> 4) + 32 * i) * lds_src + nc);
        if (ks) {
#pragma unroll
            for (int i = 0; i < 2; ++i) sc[i] = ks[k0 + (tid >> 4) + 32 * i];
        }
#pragma unroll
        for (int i = 0; i < 2; ++i) {
            const int k = (tid >> 4) + 32 * i;
            const f32x4 w = n < N ? v[i] * sc[i] : (f32x4){0.f, 0.f, 0.f, 0.f};
#pragma unroll
            for (int j = 0; j < 4; ++j) t[(nl + j) * 65 + k] = w[j];
        }
    }
    __syncthreads();
    {
        const int nl = tid >> 3, kc = (tid & 7) * 8, n = n0 + nl;
        if (n < N) {
            const float* s = t + nl * 65 + kc;
            u32x4 w;
            if (mode == 5) { w.x = pkh(s[0], s[1]); w.y = pkh(s[2], s[3]); w.z = pkh(s[4], s[5]); w.w = pkh(s[6], s[7]); }
            else { w.x = pk2(s[0], s[1]); w.y = pk2(s[2], s[3]); w.z = pk2(s[4], s[5]); w.w = pk2(s[6], s[7]); }
            *(u32x4*)(dst + (size_t)nmap(mode, n) * ldd + k0 + kc) = w;
        }
    }
    __syncthreads();
}
__device__ __forceinline__ void tconv_tile_w(char* lds, const float* src, int lds_src, bf16_t* dst, int ldd, int k0, int n0, int mode) {
    float* t = (float*)lds;
    const int tid = tidx();
    f32x4 v[8];
#pragma unroll
    for (int i = 0; i < 8; ++i) v[i] = __builtin_nontemporal_load((const f32x4*)(src + (size_t)(k0 + (tid >> 6) + 8 * i) * lds_src + n0 + (tid & 63) * 4));
#pragma unroll
    for (int i = 0; i < 8; ++i) {
        const int k = (tid >> 6) + 8 * i, nl = (tid & 63) * 4;
#pragma unroll
        for (int j = 0; j < 4; ++j) t[(nl + j) * 65 + k] = v[i][j];
    }
    __syncthreads();
#pragma unroll
    for (int j = 0; j < 4; ++j) {
        const int nl = (tid >> 3) + 64 * j, kc = (tid & 7) * 8;
        const float* sp = t + nl * 65 + kc;
        u32x4 w; w.x = pk2(sp[0], sp[1]); w.y = pk2(sp[2], sp[3]); w.z = pk2(sp[4], sp[5]); w.w = pk2(sp[6], sp[7]);
        __builtin_nontemporal_store(w, (u32x4*)(dst + (size_t)nmap(mode, n0 + nl) * ldd + k0 + kc));
    }
    __syncthreads();
}
__device__ __forceinline__ void tconv_job_w(char* lds, int local, const float* src, bf16_t* dst, int K, int N, int ldd, int mode, size_t sbs, size_t dbs) {
    const int nkt = K >> 6, nnt = N >> 8, per = nkt * nnt;
    const int b = local / per, r = local - b * per, kt = r / nnt, nt = r - kt * nnt;
    tconv_tile_w(lds, src + (size_t)b * sbs, N, dst + (size_t)b * dbs, ldd, kt * 64, nt * 256, mode);
}
__device__ __forceinline__ void tconv_job(char* lds, int local, const float* src, bf16_t* dst, int K, int N, int ldd, int mode, const float* ks, size_t sbs, size_t dbs) {
    const int nkt = K >> 6, nnt = (N + 63) >> 6, per = nkt * nnt;
    const int b = local / per, r = local - b * per, kt = r / nnt, nt = r - kt * nnt;
    tconv_tile(lds, src + (size_t)b * sbs, N, N, dst + (size_t)b * dbs, ldd, kt * 64, nt * 64, mode, ks);
}
constexpr int TC_IN0 = 16 * 19, TC_UQ = 4 * 12, TC_UKV = 2 * 16, TC_SQ = 256, TC_IN1 = 16 * 32, TC_GATE = 8 * 4, TC_MOE = 16 * 32  ;
constexpr int TC_SMALL = TC_IN0 + TC_UQ + TC_UKV + TC_SQ + TC_IN1 + 4 * TC_GATE + TC_SQ;

__device__ __forceinline__ void conv_small(const Params& p, char* lds, int id) {
    bf16_t* w = (bf16_t*)(p.ws + OFF_WS);
    if (id < TC_IN0) { tconv_job(lds, id, p.l0_w_in, w + W_IN0 / 2, 1024, 1184, 1024, 1, nullptr, 0, 0); return; } id -= TC_IN0;
    if (id < TC_UQ) { tconv_job(lds, id, p.l0_w_uq, w + W_UQ / 2, 256, 768, 256, 2, p.l0_q_norm, 0, 0); return; } id -= TC_UQ;
    if (id < TC_UKV) { tconv_job(lds, id, p.l0_w_ukv, w + W_UKV / 2, 128, 1024, 256, 0, p.l0_kv_norm, 0, 0); return; } id -= TC_UKV;
    if (id < TC_SQ) { tconv_job(lds, id, p.l0_w_out, w + W_OUT0 / 2, 1024, 1024, 1024, 0, nullptr, 0, 0); return; } id -= TC_SQ;
    if (id < TC_IN1) { tconv_job(lds, id, p.l1_w_in, w + W_IN1 / 2, 1024, 2048, 1024, 0, nullptr, 0, 0); return; } id -= TC_IN1;
    if (id < TC_GATE) { tconv_job(lds, id, p.l1_wa_f, w + W_GATE / 2, 128, 128, 128, 5, nullptr, 16384, 16384); return; } id -= TC_GATE;
    if (id < TC_GATE) { tconv_job(lds, id, p.l1_wx_f, w + W_GATE / 2 + 131072, 128, 128, 128, 5, nullptr, 16384, 16384); return; } id -= TC_GATE;
    if (id < TC_GATE) { tconv_job(lds, id, p.l1_wa_b, w + W_GATE / 2 + 2 * 131072, 128, 128, 128, 5, nullptr, 16384, 16384); return; } id -= TC_GATE;
    if (id < TC_GATE) { tconv_job(lds, id, p.l1_wx_b, w + W_GATE / 2 + 3 * 131072, 128, 128, 128, 5, nullptr, 16384, 16384); return; } id -= TC_GATE;
    tconv_job(lds, id, p.l1_w_out, w + W_OUT1 / 2, 1024, 1024, 1024, 0, nullptr, 0, 0);
}
__device__ __forceinline__ void conv_moe(const Params& p, char* lds, int id, int layer) {
    bf16_t* w = (bf16_t*)(p.ws + OFF_WMOE);
    const float* w1 = layer ? p.l1_w1 : p.l0_w1; const float* w3 = layer ? p.l1_w3 : p.l0_w3; const float* w2 = layer ? p.l1_w2 : p.l0_w2;
    if (id < TC_MOE) { tconv_job_w(lds, id, w1, w + W_UP / 2, 1024, 512, 1024, 3, (size_t)1024 * 512, (size_t)1024 * 1024); return; } id -= TC_MOE;
    if (id < TC_MOE) { tconv_job_w(lds, id, w3, w + W_UP / 2, 1024, 512, 1024, 4, (size_t)1024 * 512, (size_t)1024 * 1024); return; } id -= TC_MOE;
    tconv_job_w(lds, id, w2, w + W_DN / 2, 512, 1024, 512, 0, (size_t)512 * 1024, (size_t)1024 * 512);
}

__device__ __forceinline__ void phase_prologue(const Params& p, char* lds) {
    const int nb = gridDim.x, bid = blockIdx.x, tid = tidx();
    const int gtid = bid * NTHR + tid, gsz = nb * NTHR;
    {
        bf16_t* xb = (bf16_t*)(p.ws + OFF_RA);
        for (int i0 = gtid; i0 < T * D / 8; i0 += 4 * gsz) {
            f32x4 a[4], b[4];
#pragma unroll
            for (int j = 0; j < 4; ++j) { size_t i = (size_t)i0 + (size_t)j * gsz; if (i >= (size_t)(T * D / 8)) i = T * D / 8 - 1; a[j] = __builtin_nontemporal_load((const f32x4*)(p.x + i * 8)); b[j] = __builtin_nontemporal_load((const f32x4*)(p.x + i * 8 + 4)); }
#pragma unroll
            for (int j = 0; j < 4; ++j) { const size_t i = (size_t)i0 + (size_t)j * gsz;
                if (i < (size_t)(T * D / 8)) { u32x4 w; w.x = pk2(a[j][0], a[j][1]); w.y = pk2(a[j][2], a[j][3]); w.z = pk2(b[j][0], b[j][1]); w.w = pk2(b[j][2], b[j][3]); *(u32x4*)(xb + i * 8) = w; } }
        }
    }
    {
        float2* rt = (float2*)(p.ws + OFF_MISC + M_ROPE);
        for (int i = gtid; i < S * 16; i += gsz) {
            const int pos = i >> 4, j = i & 15;
            const float inv = powf(10000.0f, -(float)j / 16.0f);
            const float ang = (float)pos * inv;
            float sn, cs; sincosf(ang, &sn, &cs);
            rt[i] = make_float2(cs, sn);
        }
    }
    {
        float* bt = (float*)(p.ws + OFF_MISC + M_BIAS);
        for (int i = gtid; i < 8 * 257; i += gsz) {
            const int h = i / 257, rel = (i - h * 257) - 128, dist = rel < 0 ? -rel : rel;
            int bucket;
            if (dist < 8) bucket = dist;
            else { int far = 2 + (31 - __clz(dist * dist)); bucket = far < 15 ? far : 15; }
            if (rel > 0) bucket += 16;
            bt[i] = p.rel_bias[bucket * 8 + h] * LOG2E;
        }
    }
    {
        u32x4* z = (u32x4*)(p.ws + OFF_WS + W_IN0 + (size_t)1184 * 1024 * 2);
        for (int i = gtid; i < 96 * 1024 * 2 / 16; i += gsz) z[i] = (u32x4){0u, 0u, 0u, 0u};
        char* zk = p.ws + OFF_WS + W_UKV;
        for (int i = gtid; i < 1024 * 16; i += gsz) *(u32x4*)(zk + (size_t)(i >> 4) * 512 + 256 + (i & 15) * 16) = (u32x4){0u, 0u, 0u, 0u};
    }
    for (int id = bid; id < TC_SMALL; id += nb) conv_small(p, lds, id);
}
__device__ __forceinline__ void phase_prologue2(const Params& p, char* lds) {
    for (int id = blockIdx.x; id < 3 * TC_MOE; id += gridDim.x) conv_moe(p, lds, id, 0);
}

struct EpiIn0 {
    static constexpr bool PERM = true;
    const Params& p;
    __device__ __forceinline__ void operator()(f32x4 (&acc)[2][2][4][2], const pg8::Unit& u, int wr, int wc, int fr, int fq) const {
        char* rs = p.ws + OFF_RS;
#pragma unroll
        for (int ai = 0; ai < 2; ++ai)
#pragma unroll
            for (int m = 0; m < 4; ++m) {
                const int row = u.pm * 256 + ai * 128 + wr * 64 + m * 16 + fr;
#pragma unroll
                for (int bj = 0; bj < 2; ++bj) {
                    const int seg = 2 * u.pn + bj, cl = wc * 32 + fq * 8;
                    const f32x4 v0 = acc[ai][bj][m][0], v1 = acc[ai][bj][m][1];
                    if (seg <= 2) {
                        float ss = (v0[0] * v0[0] + v0[1] * v0[1]) + (v0[2] * v0[2] + v0[3] * v0[3]) + (v1[0] * v1[0] + v1[1] * v1[1]) + (v1[2] * v1[2] + v1[3] * v1[3]);
                        ss += __shfl_xor(ss, 16); ss += __shfl_xor(ss, 32);
                        const u32x2 lo = pk4(v0), hi2 = pk4(v1);
                        if (seg < 2) {
                            *(u32x4*)((bf16_t*)(rs + S_QLAT) + (size_t)row * 256 + seg * 128 + cl) = (u32x4){lo.x, lo.y, hi2.x, hi2.y};
                            if (fq == 0) ((float*)(p.ws + OFF_MISC + M_SSQQ))[row * 8 + seg * 4 + wc] = ss;
                        } else {
                            bf16_t* dst = (bf16_t*)(rs + S_KVLAT) + (size_t)row * 256 + cl;
                            *(u32x4*)dst = (u32x4){lo.x, lo.y, hi2.x, hi2.y};
                            *(u32x4*)(dst + 128) = (u32x4){0u, 0u, 0u, 0u};
                            if (fq == 0) ((float*)(p.ws + OFF_MISC + M_SSQKV))[row * 4 + wc] = ss;
                        }
                    } else if (seg <= 6) {
                        const u32x2 lo = pk4(v0 * QSCALE_SWA), hi2 = pk4(v1 * QSCALE_SWA);
                        *(u32x4*)((bf16_t*)(rs + S_QB) + (size_t)row * 512 + (seg - 3) * 128 + cl) = (u32x4){lo.x, lo.y, hi2.x, hi2.y};
                    } else if (seg <= 8) {
                        const u32x2 lo = pk4(v0), hi2 = pk4(v1);
                        *(u32x4*)((bf16_t*)(rs + (seg == 7 ? S_KB : S_VB)) + (size_t)row * 128 + cl) = (u32x4){lo.x, lo.y, hi2.x, hi2.y};
                    } else if (wc == 0) {
                        const int pos = row & (S - 1);
                        const float2* rt = (const float2*)(p.ws + OFF_MISC + M_ROPE) + pos * 16 + fq * 4;
                        f32x4 o1, o2;
#pragma unroll
                        for (int r = 0; r < 4; ++r) { const float2 cs = rt[r]; o1[r] = v0[r] * cs.x - v1[r] * cs.y; o2[r] = v0[r] * cs.y + v1[r] * cs.x; }
                        bf16_t* kd = (bf16_t*)((char*)p.out + 24 * MiB) + (size_t)row * 768 + 64 + fq * 4;
                        const u32x2 w1 = pk4(o1), w2 = pk4(o2);
#pragma unroll
                        for (int h = 0; h < 8; ++h) { *(u32x2*)(kd + h * 96) = w1; *(u32x2*)(kd + h * 96 + 16) = w2; }
                    }
                }
            }
    }
};
struct EpiIn0T4 {
    static constexpr bool PERM = true;
    const Params& p; char* lds;
    __device__ __forceinline__ void operator()(f32x4 (&acc)[2][2][4][2], const pg8::Unit& u, int wr, int wc, int fr, int fq) const {
        asm volatile("s_waitcnt vmcnt(0)" ::: "memory");
        __syncthreads();
        bf16_t* vb = (bf16_t*)(p.ws + OFF_RS + S_VB);
#pragma unroll
        for (int ai = 0; ai < 2; ++ai) {
            float2 rcs[4][4];
            if (wc == 0) {
#pragma unroll
                for (int m = 0; m < 4; ++m) {
                    const float2* rt = (const float2*)(p.ws + OFF_MISC + M_ROPE) + ((u.pm * 256 + ai * 128 + wr * 64 + m * 16 + fr) & (S - 1)) * 16 + fq * 4;
#pragma unroll
                    for (int r = 0; r < 4; ++r) rcs[m][r] = rt[r];
                }
            }
#pragma unroll
            for (int m = 0; m < 4; ++m) {
                const int lr = ai * 128 + wr * 64 + m * 16 + fr, row = u.pm * 256 + lr;
                { const u32x2 lo = pk4(acc[ai][0][m][0]), hi2 = pk4(acc[ai][0][m][1]); *(u32x4*)(vb + (size_t)row * 128 + wc * 32 + fq * 8) = (u32x4){lo.x, lo.y, hi2.x, hi2.y}; }
                if (wc == 0) {
                    const f32x4 v0 = acc[ai][1][m][0], v1 = acc[ai][1][m][1];
                    f32x4 o1, o2;
#pragma unroll
                    for (int r = 0; r < 4; ++r) { const float2 cs = rcs[m][r]; o1[r] = v0[r] * cs.x - v1[r] * cs.y; o2[r] = v0[r] * cs.y + v1[r] * cs.x; }
                    *(u32x2*)(lds + lr * 64 + fq * 8) = pk4(o1); *(u32x2*)(lds + lr * 64 + 32 + fq * 8) = pk4(o2);
                }
            }
        }
        __syncthreads();
        bf16_t* kb = (bf16_t*)((char*)p.out + 24 * MiB) + (size_t)(u.pm * 256) * 768 + 64;
        const int tid = tidx();
#pragma unroll
        for (int i = 0; i < 16; ++i) {
            const int pi = tid + 512 * i, row = pi >> 5, h = (pi >> 2) & 7, c = pi & 3;
            *(u32x4*)(kb + (size_t)row * 768 + h * 96 + c * 8) = *(const u32x4*)(lds + row * 64 + c * 16);
        }
    }
};
__device__ __forceinline__ void phase_in0(const Params& p, char* lds) {
    pg8::StaticOrder so; so.init(T, gridDim.x == 256 ? 1024 : 1280, gridDim.x, blockIdx.x);
    EpiIn0 e{p};
    pg8::gemm_phase(lds, (const bf16_t*)(p.ws + OFF_RA), (const bf16_t*)(p.ws + OFF_WS + W_IN0), 1024, so, pg8::DenseRows{}, e);
}
struct In0Tile4 {
    int c;
    __device__ bool next(int i, pg8::Unit& u) const { if (i > 0 || c >= 64) return false; u.pm = c; u.pn = 4; u.e = 0; u.valid = 256; u.lst = nullptr; return true; }
    __device__ __forceinline__ void a_ready(const pg8::Unit&) const {}
};

struct EpiQup {
    const Params& p; int m0, nt;
    __device__ __forceinline__ void operator()(f32x4 (&acc)[4][4], int wm, int wn, int fr, int fq) const {
        bf16_t* Q = (bf16_t*)p.out;
        const float* ssq = (const float*)(p.ws + OFF_MISC + M_SSQQ);
#pragma unroll
        for (int m = 0; m < 4; ++m) {
            const int row = m0 + wm * 64 + m * 16 + fr;
            const f32x4 s4 = *(const f32x4*)(ssq + row * 8), s5 = *(const f32x4*)(ssq + row * 8 + 4);
            const float sc = rsqrtf((((s4[0] + s4[1]) + (s4[2] + s4[3])) + ((s5[0] + s5[1]) + (s5[2] + s5[3]))) * (1.0f / 256.0f) + RMS_EPS) * QSCALE_MLA;
            if (nt < 4) {
                bf16_t* dst = Q + (size_t)row * 768 + (nt * 2 + wn) * 96 + fq * 4;
#pragma unroll
                for (int n = 0; n < 4; ++n) *(u32x2*)(dst + n * 16) = pk4(acc[m][n] * sc);
            } else {
                const int pos = row & (S - 1);
                const float2* rt = (const float2*)(p.ws + OFF_MISC + M_ROPE) + pos * 16 + fq * 4;
#pragma unroll
                for (int pr = 0; pr < 2; ++pr) {
                    const int h = (nt - 4) * 4 + wn * 2 + pr;
                    f32x4 o1, o2;
#pragma unroll
                    for (int r = 0; r < 4; ++r) { const float2 cs = rt[r]; const float x1 = acc[m][2 * pr][r] * sc, x2 = acc[m][2 * pr + 1][r] * sc; o1[r] = x1 * cs.x - x2 * cs.y; o2[r] = x1 * cs.y + x2 * cs.x; }
                    bf16_t* dst = Q + (size_t)row * 768 + h * 96 + 64 + fq * 4;
                    *(u32x2*)dst = pk4(o1); *(u32x2*)(dst + 16) = pk4(o2);
                }
            }
        }
    }
};
struct EpiKVup {
    const Params& p; int m0, nt;
    __device__ __forceinline__ void operator()(f32x4 (&acc)[4][4], int wm, int wn, int fr, int fq) const {
        bf16_t* Kb = (bf16_t*)((char*)p.out + 24 * MiB);
        bf16_t* Vb = (bf16_t*)(p.ws + OFF_RS + S_V);
        const float* ssq = (const float*)(p.ws + OFF_MISC + M_SSQKV);
#pragma unroll
        for (int m = 0; m < 4; ++m) {
            const int row = m0 + wm * 64 + m * 16 + fr;
            const f32x4 s4 = *(const f32x4*)(ssq + row * 4);
            const float sc = rsqrtf(((s4[0] + s4[1]) + (s4[2] + s4[3])) * (1.0f / 128.0f) + RMS_EPS);
            bf16_t* dst = wn == 0 ? Kb + (size_t)row * 768 + nt * 96 + fq * 4 : Vb + (size_t)row * 512 + nt * 64 + fq * 4;
#pragma unroll
            for (int n = 0; n < 4; ++n) *(u32x2*)(dst + n * 16) = pk4(acc[m][n] * sc);
        }
    }
};
__device__ __forceinline__ void phase_up_old(const Params& p, char* lds) {
    const bf16_t* qlat = (const bf16_t*)(p.ws + OFF_RS + S_QLAT);
    const bf16_t* kvlat = (const bf16_t*)(p.ws + OFF_RS + S_KVLAT);
    const bf16_t* wuq = (const bf16_t*)(p.ws + OFF_WS + W_UQ);
    const bf16_t* wukv = (const bf16_t*)(p.ws + OFF_WS + W_UKV);
    for (int ti = blockIdx.x; ti < 64 * 14; ti += gridDim.x) {
        const int mt = ti / 14, r = ti - mt * 14;
        if (r < 6) { EpiQup e{p, mt * 256, r}; gemm_tile(lds, plain_rows(qlat, 256, mt * 256), wuq + (size_t)r * 128 * 256, 256, 256, e); }
        else { EpiKVup e{p, mt * 256, r - 6}; gemm_tile(lds, plain_rows(kvlat, 256, mt * 256), wukv + (size_t)(r - 6) * 128 * 256, 256, 128, e); }
    }
}

struct EpiQup8 {
    static constexpr bool PERM = true;
    const Params& p;
    __device__ __forceinline__ void operator()(f32x4 (&acc)[2][2][4][2], const pg8::Unit& u, int wr, int wc, int fr, int fq) const {
        bf16_t* Q = (bf16_t*)p.out;
        float sc[2][4];
#pragma unroll
        for (int ai = 0; ai < 2; ++ai) {
            f32x4 s4[4], s5[4];
#pragma unroll
            for (int m = 0; m < 4; ++m) { const float* ssq = (const float*)(p.ws + OFF_MISC + M_SSQQ) + (u.pm * 256 + ai * 128 + wr * 64 + m * 16 + fr) * 8; s4[m] = *(const f32x4*)ssq; s5[m] = *(const f32x4*)(ssq + 4); }
#pragma unroll
            for (int m = 0; m < 4; ++m) sc[ai][m] = rsqrtf((((s4[m][0] + s4[m][1]) + (s4[m][2] + s4[m][3])) + ((s5[m][0] + s5[m][1]) + (s5[m][2] + s5[m][3]))) * (1.0f / 256.0f) + RMS_EPS) * QSCALE_MLA;
        }
        if (u.pn < 2) {
#pragma unroll
            for (int ai = 0; ai < 2; ++ai)
#pragma unroll
                for (int m = 0; m < 4; ++m) {
                    const int row = u.pm * 256 + ai * 128 + wr * 64 + m * 16 + fr; const float scr = sc[ai][m];
#pragma unroll
                    for (int bj = 0; bj < 2; ++bj) {
                        const u32x2 lo = pk4(acc[ai][bj][m][0] * scr), hi2 = pk4(acc[ai][bj][m][1] * scr);
                        *(u32x4*)(Q + (size_t)row * 768 + (4 * u.pn + 2 * bj + (wc >> 1)) * 96 + (wc & 1) * 32 + fq * 8) = (u32x4){lo.x, lo.y, hi2.x, hi2.y};
                    }
                }
        } else {
#pragma unroll
            for (int ai = 0; ai < 2; ++ai) {
                float2 cs[4][4];
#pragma unroll
                for (int m = 0; m < 4; ++m) {
                    const float2* rt = (const float2*)(p.ws + OFF_MISC + M_ROPE) + ((u.pm * 256 + ai * 128 + wr * 64 + m * 16 + fr) & (S - 1)) * 16 + fq * 4;
#pragma unroll
                    for (int r = 0; r < 4; ++r) cs[m][r] = rt[r];
                }
#pragma unroll
                for (int m = 0; m < 4; ++m) {
                    const int row = u.pm * 256 + ai * 128 + wr * 64 + m * 16 + fr; const float scr = sc[ai][m];
                    f32x4 cv, sv;
#pragma unroll
                    for (int r = 0; r < 4; ++r) { cv[r] = cs[m][r].x * scr; sv[r] = cs[m][r].y * scr; }
#pragma unroll
                    for (int bj = 0; bj < 2; ++bj) {
                        const f32x4 v0 = acc[ai][bj][m][0], v1 = acc[ai][bj][m][1];
                        bf16_t* dst = Q + (size_t)row * 768 + (4 * bj + wc) * 96 + 64 + fq * 4;
                        *(u32x2*)dst = pk4(v0 * cv - v1 * sv); *(u32x2*)(dst + 16) = pk4(v0 * sv + v1 * cv);
                    }
                }
            }
        }
    }
};
struct EpiKVup8 {
    static constexpr bool PERM = true;
    const Params& p;
    __device__ __forceinline__ void operator()(f32x4 (&acc)[2][2][4][2], const pg8::Unit& u, int wr, int wc, int fr, int fq) const {
        bf16_t* Kb = (bf16_t*)((char*)p.out + 24 * MiB);
        bf16_t* Vb = (bf16_t*)(p.ws + OFF_RS + S_V);
        const float* ssq = (const float*)(p.ws + OFF_MISC + M_SSQKV);
        float scs[2][4];
        {
            f32x4 s4[2][4];
#pragma unroll
            for (int ai = 0; ai < 2; ++ai)
#pragma unroll
                for (int m = 0; m < 4; ++m) s4[ai][m] = *(const f32x4*)(ssq + (u.pm * 256 + ai * 128 + wr * 64 + m * 16 + fr) * 4);
#pragma unroll
            for (int ai = 0; ai < 2; ++ai)
#pragma unroll
                for (int m = 0; m < 4; ++m) scs[ai][m] = rsqrtf(((s4[ai][m][0] + s4[ai][m][1]) + (s4[ai][m][2] + s4[ai][m][3])) * (1.0f / 128.0f) + RMS_EPS);
        }
#pragma unroll
        for (int ai = 0; ai < 2; ++ai)
#pragma unroll
            for (int m = 0; m < 4; ++m) {
                const int row = u.pm * 256 + ai * 128 + wr * 64 + m * 16 + fr;
                const float sc = scs[ai][m];
#pragma unroll
                for (int bj = 0; bj < 2; ++bj) {
                    const int h = 2 * u.pn + bj;
                    bf16_t* dst = wc < 2 ? Kb + (size_t)row * 768 + h * 96 + wc * 32 + fq * 8 : Vb + (size_t)row * 512 + h * 64 + (wc - 2) * 32 + fq * 8;
                    const u32x2 lo = pk4(acc[ai][bj][m][0] * sc), hi2 = pk4(acc[ai][bj][m][1] * sc);
                    *(u32x4*)dst = (u32x4){lo.x, lo.y, hi2.x, hi2.y};
                }
            }
    }
};
static_assert(W_UKV == W_UQ + 768 * 256 * 2 && S_KVLAT == S_QLAT + (size_t)T * 256 * 2, "q-up / kv-up operands are adjacent");
struct UpRows { __device__ __forceinline__ unsigned rowoff(const pg8::Unit& u, int row, int K) const { return (u.pn >= 3 ? (unsigned)(S_KVLAT - S_QLAT) : 0u) + (unsigned)(u.pm * pg8::BM + row) * (unsigned)K * 2u; } };
struct EpiUp8 {
    static constexpr bool PERM = true;
    const Params& p;
    __device__ __forceinline__ void operator()(f32x4 (&acc)[2][2][4][2], const pg8::Unit& u, int wr, int wc, int fr, int fq) const {
        if (u.pn < 3) { EpiQup8 e{p}; e(acc, u, wr, wc, fr, fq); }
        else { pg8::Unit u2 = u; u2.pn = u.pn - 3; EpiKVup8 e{p}; e(acc, u2, wr, wc, fr, fq); }
    }
};
__device__ __forceinline__ void phase_up(const Params& p, char* lds) {
    if (gridDim.x == 256) {
        if (blockIdx.x < 64) {
            In0Tile4 so{(int)blockIdx.x}; EpiIn0T4 e{p, lds};
            pg8::gemm_phase(lds, (const bf16_t*)(p.ws + OFF_RA), (const bf16_t*)(p.ws + OFF_WS + W_IN0), 1024, so, pg8::DenseRows{}, e);
        } else {
            pg8::StaticOrder so; so.init(T, 768 + 1024, 192, blockIdx.x - 64); EpiUp8 e{p};
            pg8::gemm_phase(lds, (const bf16_t*)(p.ws + OFF_RS + S_QLAT), (const bf16_t*)(p.ws + OFF_WS + W_UQ), 256, so, UpRows{}, e);
        }
    } else {
        { pg8::StaticOrder so; so.init(T, 768, gridDim.x, blockIdx.x); EpiQup8 e{p};
          pg8::gemm_phase(lds, (const bf16_t*)(p.ws + OFF_RS + S_QLAT), (const bf16_t*)(p.ws + OFF_WS + W_UQ), 256, so, pg8::DenseRows{}, e); }
        { pg8::StaticOrder so; so.init(T, 1024, gridDim.x, blockIdx.x); EpiKVup8 e{p};
          pg8::gemm_phase(lds, (const bf16_t*)(p.ws + OFF_RS + S_KVLAT), (const bf16_t*)(p.ws + OFF_WS + W_UKV), 256, so, pg8::DenseRows{}, e); }
    }
}

__device__ __forceinline__ s16x4 vtr(const char* pl) {
    typedef short v4i16_t __attribute__((ext_vector_type(4)));
    return __builtin_bit_cast(s16x4, __builtin_amdgcn_ds_read_tr16_b64_v4i16((LAS v4i16_t*)(LAS char*)pl));
}
constexpr float ATT_THR = 8.0f;
constexpr bool MLA_V2 = true;
#define MX3(a, b, c) __builtin_fmaxf(__builtin_fmaxf((a), (b)), (c))
__device__ __forceinline__ void softmax_pv(f32x16& s0, f32x16& s1, float& mrun, float& lrun, f32x16 (&o)[2], f32x16& cinit, bool first, const char* vt, int dstride, float* af, int lane) {
    const int r32 = lane & 31, hi = lane >> 5;
    float ma = MX3(s0[0], s0[1], s1[0]), mb = MX3(s0[2], s0[3], s1[1]); ma = MX3(ma, s1[2], s1[3]);
#pragma unroll
    for (int r = 4; r < 16; r += 4) { ma = MX3(ma, s0[r], s0[r + 1]); mb = MX3(mb, s0[r + 2], s0[r + 3]); ma = MX3(ma, s1[r], s1[r + 1]); mb = MX3(mb, s1[r + 2], s1[r + 3]); }
    float mx = __builtin_fmaxf(ma, mb);
    mx = __builtin_fmaxf(mx, __shfl_xor(mx, 32));
    if (__any(first || mx > ATT_THR)) {
        const float delta = first ? mx : __builtin_fmaxf(mx, 0.0f);
        mrun += delta;
#pragma unroll
        for (int r = 0; r < 16; ++r) { s0[r] -= delta; s1[r] -= delta; cinit[r] = -mrun; }
        if (!first) {
            const float alpha = __builtin_amdgcn_exp2f(-delta);
            lrun *= alpha;
            if (hi == 0) af[r32] = alpha;
#pragma unroll
            for (int r = 0; r < 16; ++r) { const float a = af[crow(r, hi)]; o[0][r] *= a; o[1][r] *= a; }
        }
    }
    float ls = 0.f;
#pragma unroll
    for (int r = 0; r < 16; ++r) { s0[r] = __builtin_amdgcn_exp2f(s0[r]); s1[r] = __builtin_amdgcn_exp2f(s1[r]); ls += s0[r] + s1[r]; }
    lrun += ls;
    bf16x8 pw[4];
#pragma unroll
    for (int s = 0; s < 4; ++s) {
        u32x4 w;
        if (s < 2) { w.x = pk2(s0[8 * s], s0[8 * s + 1]); w.y = pk2(s0[8 * s + 2], s0[8 * s + 3]); w.z = pk2(s0[8 * s + 4], s0[8 * s + 5]); w.w = pk2(s0[8 * s + 6], s0[8 * s + 7]); }
        else { const int q = s - 2; w.x = pk2(s1[8 * q], s1[8 * q + 1]); w.y = pk2(s1[8 * q + 2], s1[8 * q + 3]); w.z = pk2(s1[8 * q + 4], s1[8 * q + 5]); w.w = pk2(s1[8 * q + 6], s1[8 * q + 7]); }
        pw[s] = __builtin_bit_cast(bf16x8, w);
    }
    const char* vp = vt + ((lane >> 4) & 1) * 32 + (lane & 3) * 8 + (4 * hi + ((lane & 15) >> 2)) * 64;
#pragma unroll
    for (int d0 = 0; d0 < 2; ++d0)
#pragma unroll
        for (int s = 0; s < 4; ++s) {
            const s16x4 lo = vtr(vp + d0 * dstride + s * 1024), hh = vtr(vp + d0 * dstride + s * 1024 + 512);
            const bf16x8 vf = (bf16x8){lo[0], lo[1], lo[2], lo[3], hh[0], hh[1], hh[2], hh[3]};
            o[d0] = MFMA32(pw[s], vf, o[d0]);
        }
}
__device__ __forceinline__ void attn_store(const f32x16 (&o)[2], float lrun, float* af, bf16_t* dst  , int lane) {
    const int r32 = lane & 31, hi = lane >> 5;
    const float lt = lrun + __shfl_xor(lrun, 32);
    if (hi == 0) af[r32] = 1.0f / lt;
#pragma unroll
    for (int r = 0; r < 16; ++r) {
        const int q = crow(r, hi); const float li = af[q];
        dst[(size_t)q * 1024 + r32] = f2bf(o[0][r] * li);
        dst[(size_t)q * 1024 + 32 + r32] = f2bf(o[1][r] * li);
    }
}

constexpr int MLA_KROW = 208, MLA_KB = 64 * MLA_KROW, MLA_VB = 8192, MLA_STAGE = MLA_KB + MLA_VB, MLA_AF = 2 * MLA_STAGE;
__device__ __forceinline__ void mla_unit(const Params& p, char* lds, int b, int h, int qb) {
    const int tid = tidx(), lane = tid & 63, wid = tid >> 6, r32 = lane & 31, hi = lane >> 5;
    const bf16_t* Q = (const bf16_t*)p.out;
    const bf16_t* Kg = (const bf16_t*)((const char*)p.out + 24 * MiB) + (size_t)b * S * 768 + h * 96;
    const bf16_t* Vg = (const bf16_t*)(p.ws + OFF_RS + S_V) + (size_t)b * S * 512 + h * 64;
    float* af = (float*)(lds + MLA_AF) + wid * 32;
    bf16x8 qf[6];
    {
        const bf16_t* qp = Q + (size_t)(b * S + qb * 256 + wid * 32 + r32) * 768 + h * 96 + hi * 8;
#pragma unroll
        for (int ks = 0; ks < 6; ++ks) qf[ks] = *(const bf16x8*)(qp + ks * 16);
    }
    const int k_id1 = tid + 512;
    const int kr0 = tid / 12, kc0 = tid - kr0 * 12, kr1 = k_id1 / 12, kc1 = k_id1 - kr1 * 12;
    const bool k2 = k_id1 < 768;
    const int vr = tid >> 3, vc = tid & 7;
    const int kst0 = kr0 * MLA_KROW + kc0 * 16, kst1 = kr1 * MLA_KROW + kc1 * 16, vst = MLA_KB + (vc >> 2) * 4096 + vr * 64 + (vc & 3) * 16;
    const bf16_t* kp0 = Kg + (size_t)kr0 * 768 + kc0 * 8;
    const bf16_t* kp1 = Kg + (size_t)kr1 * 768 + kc1 * 8;
    const bf16_t* vp = Vg + (size_t)vr * 512 + vc * 8;
    u32x4 rk0, rk1, rv;
    rk0 = *(const u32x4*)kp0; if (k2) rk1 = *(const u32x4*)kp1; rv = *(const u32x4*)vp;
    *(u32x4*)(lds + kst0) = rk0; if (k2) *(u32x4*)(lds + kst1) = rk1; *(u32x4*)(lds + vst) = rv;
    __syncthreads();
    float mrun = 0.f, lrun = 0.f;
    f32x16 cinit = (f32x16){};
    f32x16 o[2]; o[0] = (f32x16){}; o[1] = (f32x16){};
    constexpr int NT = S / 64;
    for (int t = 0; t < NT; ++t) {
        const char* cur = lds + (t & 1) * MLA_STAGE; char* nxt = lds + ((t + 1) & 1) * MLA_STAGE;
        const bool more = t + 1 < NT;
        if (more) { const size_t go = (size_t)(t + 1) * 64; rk0 = *(const u32x4*)(kp0 + go * 768); if (k2) rk1 = *(const u32x4*)(kp1 + go * 768); rv = *(const u32x4*)(vp + go * 512); }
        f32x16 s0 = cinit, s1 = cinit;
#pragma unroll
        for (int ks = 0; ks < 6; ++ks) {
            const bf16x8 k0 = *(const bf16x8*)(cur + r32 * MLA_KROW + (ks * 2 + hi) * 16);
            const bf16x8 k1 = *(const bf16x8*)(cur + (32 + r32) * MLA_KROW + (ks * 2 + hi) * 16);
            s0 = MFMA32(k0, qf[ks], s0); s1 = MFMA32(k1, qf[ks], s1);
        }
        softmax_pv(s0, s1, mrun, lrun, o, cinit, t == 0, cur + MLA_KB, 4096, af, lane);
        if (more) { *(u32x4*)(nxt + kst0) = rk0; if (k2) *(u32x4*)(nxt + kst1) = rk1; *(u32x4*)(nxt + vst) = rv; }
        __syncthreads();
    }
    bf16_t* dst = (bf16_t*)(p.ws + OFF_RS + S_CAT) + (size_t)(b * S + qb * 256 + wid * 32) * 1024 + h * 64;
    attn_store(o, lrun, af, dst, lane);
}

namespace mla2 {
constexpr int SLK = 12288, SLV = 8192, LDS_K = 0, LDS_V = 4 * SLK, LDS_WS = LDS_V + 3 * SLV, LDS_OST = LDS_WS + 8 * 256, LDS_END = LDS_OST + 8 * 4096;
constexpr int KP = 768, VP = 512, NT = S / 64;
typedef __attribute__((address_space(3))) const char* lds_cptr;
__device__ __forceinline__ void glds16(const void* g, unsigned lds_dst) {
    unsigned keep; asm volatile("s_mov_b32 %0, m0\n\ts_mov_b32 m0, %2\n\ts_nop 0\n\tglobal_load_lds_dwordx4 %1, off\n\ts_mov_b32 m0, %0" : "=&s"(keep) : "v"(g), "s"(lds_dst) : "memory"); }
typedef float f32x2_t __attribute__((ext_vector_type(2))); typedef __bf16 bf16x2_t __attribute__((ext_vector_type(2)));
__device__ __forceinline__ unsigned cvtpk_s(float lo, float hi) { f32x2_t v = {lo, hi}; bf16x2_t b = __builtin_convertvector(v, bf16x2_t); return __builtin_bit_cast(unsigned, b); }
__device__ __forceinline__ void kload2(bf16x8* kf, lds_cptr kp, int j) { kf[2 * j] = *(const __attribute__((address_space(3))) bf16x8*)(kp + j * 2048); kf[2 * j + 1] = *(const __attribute__((address_space(3))) bf16x8*)(kp + j * 2048 + 512); }
__device__ __forceinline__ s16x4 vtr3(lds_cptr pl) { typedef short v4i16_t __attribute__((ext_vector_type(4))); return __builtin_bit_cast(s16x4, __builtin_amdgcn_ds_read_tr16_b64_v4i16((__attribute__((address_space(3))) v4i16_t*)pl)); }
#define M2_SBAR() __builtin_amdgcn_sched_barrier(0)
#define M2_PIN(x) asm volatile("" : "+v"(x))
#define M2_WAIT_BAR(N) asm volatile("s_waitcnt vmcnt(" #N ") lgkmcnt(0)\n\ts_barrier" ::: "memory")
#define M2_MF(a, b, c) __builtin_amdgcn_mfma_f32_32x32x16_bf16(a, b, c, 0, 0, 0)
__device__ __forceinline__ void unit(const bf16_t* Q, const bf16_t* K, const bf16_t* V, bf16_t* O, char* shm, int b, int h, int qb) {
    const int tid = tidx(), lane = tid & 63, r32 = lane & 31, hi = lane >> 5; const int wid = __builtin_amdgcn_readfirstlane(tid >> 6);
    const bool w4 = wid < 4;
    const long rowbase = (long)b * S; const int q0 = qb * 256;
    const bf16_t* Qw = Q + (rowbase + q0 + wid * 32) * KP + h * 96;
    const bf16_t* Kh = K + rowbase * KP + h * 96; const bf16_t* Vh = V + rowbase * VP + h * 64;
    const unsigned lds0 = (unsigned)(uintptr_t)shm;
    float* wsf = (float*)(shm + LDS_WS) + wid * 64;
    const bf16_t* ksrc = Kh + (long)lane * KP + wid * 8;
    const bf16_t* ksrc2 = Kh + (long)lane * KP + (8 + (wid & 3)) * 8;
    const bf16_t* vsrc = Vh + (long)(16 * (wid & 3) + (lane >> 2)) * VP + (wid >> 2) * 32 + (lane & 3) * 8;
    const unsigned kdst = lds0 + LDS_K + wid * 1024, kdst2 = lds0 + LDS_K + (8 + (wid & 3)) * 1024, vdst = lds0 + LDS_V + wid * 1024;
#define M2_DMA_K(t, slot) do { glds16(ksrc + (long)(t) * 64 * KP, (unsigned)__builtin_amdgcn_readfirstlane(kdst + (slot))); if (w4) glds16(ksrc2 + (long)(t) * 64 * KP, (unsigned)__builtin_amdgcn_readfirstlane(kdst2 + (slot))); } while (0)
#define M2_DMA_V(t, slot) glds16(vsrc + (long)(t) * 64 * VP, (unsigned)__builtin_amdgcn_readfirstlane(vdst + (slot)))
#define M2_WAITS() do { if (w4) { M2_WAIT_BAR(3); } else { M2_WAIT_BAR(2); } } while (0)
    const lds_cptr shm3 = (lds_cptr)shm; const lds_cptr kp0 = shm3 + LDS_K + hi * 1024 + r32 * 16;
    const lds_cptr vp0 = shm3 + LDS_V + ((lane >> 4) & 1) * 32 + (lane & 3) * 8 + (4 * hi + ((lane & 15) >> 2)) * 64;
    M2_DMA_K(0, 0); M2_DMA_V(0, 0); M2_DMA_K(1, SLK);
    bf16x8 qr[6];
#pragma unroll
    for (int d0 = 0; d0 < 6; ++d0) qr[d0] = *(const bf16x8*)(Qw + (long)r32 * KP + d0 * 16 + hi * 8);
    float mhat = 0.f, l_reg = 0.f; f32x16 o[2]; o[0] = (f32x16){}; o[1] = (f32x16){}; f32x16 negm = (f32x16){}; M2_PIN(negm);
    bool resc = false;
    f32x16 pA0, pA1, pB0, pB1; bf16x8 kf[12]; s16x4 vlo[8], vhi[8]; u32x4 pw0, pw1, pw2, pw3;
    int vs_prev = 0, vs_cur = 0, vs_next = SLV;
#define M2_ROT() do { vs_prev = vs_cur; vs_cur = vs_next; vs_next = (vs_next == 2 * SLV) ? 0 : vs_next + SLV; } while (0)
#define M2_KS(t) (((t) & 3) * SLK)
    M2_DMA_K(2, 2 * SLK);
    if (w4) { M2_WAIT_BAR(5); } else { M2_WAIT_BAR(3); }
#pragma unroll
    for (int j = 0; j < 6; ++j) kload2(kf, kp0, j);
    pA0 = M2_MF(kf[0], qr[0], negm); pA1 = M2_MF(kf[1], qr[0], negm);
#pragma unroll
    for (int j = 1; j < 6; ++j) { pA0 = M2_MF(kf[2 * j], qr[j], pA0); pA1 = M2_MF(kf[2 * j + 1], qr[j], pA1); }
    {
        float a = MX3(pA0[0], pA0[1], pA1[0]), bq = MX3(pA0[2], pA0[3], pA1[1]); a = MX3(a, pA1[2], pA1[3]);
#pragma unroll
        for (int r = 4; r < 16; r += 4) { a = MX3(a, pA0[r], pA0[r + 1]); bq = MX3(bq, pA0[r + 2], pA0[r + 3]); a = MX3(a, pA1[r], pA1[r + 1]); bq = MX3(bq, pA1[r + 2], pA1[r + 3]); }
        float rm = __builtin_fmaxf(a, bq); { auto rr = __builtin_amdgcn_permlane32_swap(__float_as_uint(rm), __float_as_uint(rm), false, false); rm = __builtin_fmaxf(__uint_as_float(rr[0]), __uint_as_float(rr[1])); }
        mhat = rm;
#pragma unroll
        for (int r = 0; r < 16; ++r) { pA0[r] = __builtin_amdgcn_exp2f(pA0[r] - rm); pA1[r] = __builtin_amdgcn_exp2f(pA1[r] - rm); negm[r] = -mhat; }
        M2_PIN(negm);
    }
    M2_WAIT_BAR(0);
    M2_DMA_K(3, 3 * SLK); M2_DMA_V(1, SLV); M2_ROT();
#pragma unroll
    for (int j = 0; j < 4; ++j) kload2(kf, kp0 + M2_KS(1), j);
#define M2_PKW(P, B) cvtpk_s(P[B], P[B + 1])
#define M2_PAF(k) __builtin_bit_cast(bf16x8, pw##k)
#define M2_VFR(i) (bf16x8){vlo[i][0], vlo[i][1], vlo[i][2], vlo[i][3], vhi[i][0], vhi[i][1], vhi[i][2], vhi[i][3]}
#define M2_VRD(i) do { vlo[i] = vtr3(vp_ + (((i) >> 2) * 4096 + ((i) & 3) * 1024)); vhi[i] = vtr3(vp_ + (((i) >> 2) * 4096 + ((i) & 3) * 1024 + 512)); } while (0)
#define M2_EX(v) __builtin_amdgcn_exp2f(v)
#define M2_GAPB(MF, X, B) do { MF; X[B] = M2_EX(X[B]); X[B + 1] = M2_EX(X[B + 1]); X[B + 2] = M2_EX(X[B + 2]); X[B + 3] = M2_EX(X[B + 3]); M2_PIN(X); M2_SBAR(); } while (0)
#define M2_KRD(G, kb, j) do { if (G) { kload2(kf, kp0 + (kb), j); M2_SBAR(); } } while (0)
#define M2_STEP(C0, C1, P0, P1, t, GK, GV, GL) do { M2_SBAR(); \
    const lds_cptr vp_ = vp0 + vs_prev; const int kc_ = M2_KS(t), kn_ = M2_KS((t) + 1); \
    M2_VRD(0); M2_SBAR(); float sacc = P0[0] + P0[1]; \
    C0 = M2_MF(kf[0], qr[0], negm); sacc += P0[2]; sacc += P0[3]; sacc += P0[4]; M2_PIN(sacc); pw0[0] = M2_PKW(P0, 0); pw0[1] = M2_PKW(P0, 2); M2_PIN(pw0); M2_SBAR(); \
    M2_VRD(4); M2_SBAR(); \
    C1 = M2_MF(kf[1], qr[0], negm); sacc += P0[5]; sacc += P0[6]; sacc += P0[7]; M2_PIN(sacc); pw0[2] = M2_PKW(P0, 4); pw0[3] = M2_PKW(P0, 6); M2_PIN(pw0); M2_SBAR(); \
    M2_VRD(1); M2_SBAR(); \
    C0 = M2_MF(kf[2], qr[1], C0); sacc += P0[8]; sacc += P0[9]; sacc += P0[10]; M2_PIN(sacc); pw1[0] = M2_PKW(P0, 8); pw1[1] = M2_PKW(P0, 10); M2_PIN(pw1); M2_SBAR(); \
    M2_VRD(5); M2_SBAR(); \
    C1 = M2_MF(kf[3], qr[1], C1); sacc += P0[11]; sacc += P0[12]; sacc += P0[13]; M2_PIN(sacc); pw1[2] = M2_PKW(P0, 12); pw1[3] = M2_PKW(P0, 14); M2_PIN(pw1); M2_SBAR(); \
    M2_VRD(2); kload2(kf, kp0 + kc_, 4); M2_SBAR();                                                         \
    C0 = M2_MF(kf[4], qr[2], C0); sacc += P0[14]; sacc += P0[15]; sacc += P1[0]; M2_PIN(sacc); pw2[0] = M2_PKW(P1, 0); M2_PIN(pw2); M2_SBAR(); \
    M2_VRD(6); kload2(kf, kp0 + kc_, 5); M2_SBAR(); \
    C1 = M2_MF(kf[5], qr[2], C1); sacc += P1[1]; sacc += P1[2]; sacc += P1[3]; M2_PIN(sacc); pw2[1] = M2_PKW(P1, 2); M2_PIN(pw2); M2_SBAR(); \
    M2_VRD(3); M2_SBAR(); \
    C0 = M2_MF(kf[6], qr[3], C0); sacc += P1[4]; sacc += P1[5]; M2_PIN(sacc); pw2[2] = M2_PKW(P1, 4); M2_PIN(pw2); M2_SBAR(); \
    M2_VRD(7); M2_SBAR(); \
    C1 = M2_MF(kf[7], qr[3], C1); sacc += P1[6]; sacc += P1[7]; M2_PIN(sacc); pw2[3] = M2_PKW(P1, 6); M2_PIN(pw2); M2_SBAR(); \
    C0 = M2_MF(kf[8], qr[4], C0); sacc += P1[8]; sacc += P1[9]; M2_PIN(sacc); pw3[0] = M2_PKW(P1, 8); M2_PIN(pw3); M2_SBAR(); \
    C1 = M2_MF(kf[9], qr[4], C1); sacc += P1[10]; sacc += P1[11]; M2_PIN(sacc); pw3[1] = M2_PKW(P1, 10); M2_PIN(pw3); M2_SBAR(); \
    C0 = M2_MF(kf[10], qr[5], C0); sacc += P1[12]; sacc += P1[13]; M2_PIN(sacc); pw3[2] = M2_PKW(P1, 12); M2_PIN(pw3); M2_SBAR(); \
    C1 = M2_MF(kf[11], qr[5], C1); sacc += P1[14]; sacc += P1[15]; M2_PIN(sacc); pw3[3] = M2_PKW(P1, 14); M2_PIN(pw3); M2_SBAR(); \
    l_reg += sacc; \
    if (GK) { M2_DMA_K((t) + 3, M2_KS((t) + 3)); } if (GV) { M2_DMA_V((t) + 1, vs_next); } \
    { float a = MX3(C0[0], C0[1], C1[0]), bq = MX3(C0[2], C0[3], C1[1]); a = MX3(a, C1[2], C1[3]); \
      _Pragma("unroll") for (int r = 4; r < 16; r += 4) { a = MX3(a, C0[r], C0[r + 1]); bq = MX3(bq, C0[r + 2], C0[r + 3]); a = MX3(a, C1[r], C1[r + 1]); bq = MX3(bq, C1[r + 2], C1[r + 3]); } \
      float rm = __builtin_fmaxf(a, bq); { auto rr = __builtin_amdgcn_permlane32_swap(__float_as_uint(rm), __float_as_uint(rm), false, false); rm = __builtin_fmaxf(__uint_as_float(rr[0]), __uint_as_float(rr[1])); } \
      resc = false; \
      if (__builtin_expect(__any(rm > ATT_THR), 0)) { const float dl = __builtin_fmaxf(rm, 0.f); mhat += dl; \
        _Pragma("unroll") for (int r = 0; r < 16; ++r) { C0[r] -= dl; C1[r] -= dl; } \
        _Pragma("unroll") for (int r = 0; r < 16; ++r) negm[r] = -mhat; M2_PIN(negm); \
        const float f = __builtin_amdgcn_exp2f(-dl); l_reg *= f; if (hi == 0) wsf[r32] = f; resc = true; } } \
    M2_SBAR(); \
    M2_GAPB(o[0] = M2_MF(M2_PAF(0), M2_VFR(0), o[0]), C0, 0); \
    M2_KRD(GL, kn_, 0); M2_GAPB(o[1] = M2_MF(M2_PAF(0), M2_VFR(4), o[1]), C0, 4); \
    M2_KRD(GL, kn_, 1); M2_GAPB(o[0] = M2_MF(M2_PAF(1), M2_VFR(1), o[0]), C0, 8); \
    M2_KRD(GL, kn_, 2); M2_GAPB(o[1] = M2_MF(M2_PAF(1), M2_VFR(5), o[1]), C0, 12); \
    M2_KRD(GL, kn_, 3); M2_GAPB(o[0] = M2_MF(M2_PAF(2), M2_VFR(2), o[0]), C1, 0); \
    M2_GAPB(o[1] = M2_MF(M2_PAF(2), M2_VFR(6), o[1]), C1, 4); \
    M2_GAPB(o[0] = M2_MF(M2_PAF(3), M2_VFR(3), o[0]), C1, 8); \
    M2_GAPB(o[1] = M2_MF(M2_PAF(3), M2_VFR(7), o[1]), C1, 12); \
    } while (0)
#define M2_RESC() do { if (resc) { asm volatile("s_waitcnt lgkmcnt(0)" ::: "memory"); \
      _Pragma("unroll") for (int d_ = 0; d_ < 2; ++d_) _Pragma("unroll") for (int r = 0; r < 16; ++r) o[d_][r] *= wsf[crow(r, hi)]; } } while (0)
#define M2_ENDW(tt) do { if ((tt) + 3 < NT) { M2_WAITS(); } else if ((tt) + 2 < NT) { M2_WAIT_BAR(1); } else { M2_WAIT_BAR(0); } } while (0)
    M2_WAIT_BAR(0);
    int t = 1;
    for (; t + 5 < NT; t += 2) {
        M2_STEP(pB0, pB1, pA0, pA1, t, true, true, true);     M2_WAITS(); M2_RESC(); M2_ROT();
        M2_STEP(pA0, pA1, pB0, pB1, t + 1, true, true, true); M2_WAITS(); M2_RESC(); M2_ROT();
    }
    for (; t + 1 < NT; t += 2) {
        M2_STEP(pB0, pB1, pA0, pA1, t, (t + 3 < NT), (t + 1 < NT), (t + 1 < NT));         M2_ENDW(t);     M2_RESC(); M2_ROT();
        M2_STEP(pA0, pA1, pB0, pB1, t + 1, (t + 4 < NT), (t + 2 < NT), (t + 2 < NT));     M2_ENDW(t + 1); M2_RESC(); M2_ROT();
    }
    M2_STEP(pB0, pB1, pA0, pA1, NT - 1, false, false, false); M2_RESC();
    {
        float sacc = pB0[0] + pB0[1];
#pragma unroll
        for (int r = 2; r < 16; ++r) sacc += pB0[r];
#pragma unroll
        for (int r = 0; r < 16; ++r) sacc += pB1[r];
        l_reg += sacc;
        pw0 = (u32x4){M2_PKW(pB0, 0), M2_PKW(pB0, 2), M2_PKW(pB0, 4), M2_PKW(pB0, 6)}; pw1 = (u32x4){M2_PKW(pB0, 8), M2_PKW(pB0, 10), M2_PKW(pB0, 12), M2_PKW(pB0, 14)};
        pw2 = (u32x4){M2_PKW(pB1, 0), M2_PKW(pB1, 2), M2_PKW(pB1, 4), M2_PKW(pB1, 6)}; pw3 = (u32x4){M2_PKW(pB1, 8), M2_PKW(pB1, 10), M2_PKW(pB1, 12), M2_PKW(pB1, 14)};
        const lds_cptr vp_ = vp0 + vs_cur;
#pragma unroll
        for (int i = 0; i < 8; ++i) M2_VRD(i);
        o[0] = M2_MF(M2_PAF(0), M2_VFR(0), o[0]); o[1] = M2_MF(M2_PAF(0), M2_VFR(4), o[1]); o[0] = M2_MF(M2_PAF(1), M2_VFR(1), o[0]); o[1] = M2_MF(M2_PAF(1), M2_VFR(5), o[1]);
        o[0] = M2_MF(M2_PAF(2), M2_VFR(2), o[0]); o[1] = M2_MF(M2_PAF(2), M2_VFR(6), o[1]); o[0] = M2_MF(M2_PAF(3), M2_VFR(3), o[0]); o[1] = M2_MF(M2_PAF(3), M2_VFR(7), o[1]);
    }
    { auto rr = __builtin_amdgcn_permlane32_swap(__float_as_uint(l_reg), __float_as_uint(l_reg), false, false); l_reg = __uint_as_float(rr[0]) + __uint_as_float(rr[1]); }
    if (hi == 0) wsf[32 + r32] = l_reg;
    asm volatile("s_waitcnt lgkmcnt(0)" ::: "memory");
    float rli[16];
#pragma unroll
    for (int r = 0; r < 16; ++r) rli[r] = __builtin_amdgcn_rcpf(wsf[32 + crow(r, hi)]);
    bf16_t* Ow = O + (rowbase + q0 + wid * 32) * 1024 + h * 64; bf16_t* stg = (bf16_t*)(shm + LDS_OST) + wid * 2048;
#pragma unroll
    for (int r = 0; r < 16; ++r) { const int orow = crow(r, hi);
#pragma unroll
        for (int d0 = 0; d0 < 2; ++d0) stg[orow * 64 + d0 * 32 + r32] = f2bf(o[d0][r] * rli[r]); }
    asm volatile("s_waitcnt lgkmcnt(0)" ::: "memory");
#pragma unroll
    for (int i = 0; i < 4; ++i) { const int row = i * 8 + (lane >> 3), ch = lane & 7; *(u32x4*)(Ow + (long)row * 1024 + ch * 8) = *(const u32x4*)(stg + row * 64 + ch * 8); }
    asm volatile("s_waitcnt lgkmcnt(0)\n\ts_barrier" ::: "memory");
#undef M2_DMA_K
#undef M2_DMA_V
#undef M2_WAITS
#undef M2_ROT
#undef M2_KS
#undef M2_PKW
#undef M2_PAF
#undef M2_VFR
#undef M2_VRD
#undef M2_EX
#undef M2_GAPB
#undef M2_KRD
#undef M2_STEP
#undef M2_RESC
#undef M2_ENDW
}
}

constexpr int SWA_KROW = 144, SWA_KB = 384 * SWA_KROW, SWA_VB = 2 * 384 * 64, SWA_BIAS = SWA_KB + SWA_VB, SWA_AF = SWA_BIAS + 4 * 512 * 4;
__device__ __forceinline__ void swa_unit(const Params& p, char* lds, int b, int nblk, int g) {
    const int tid = tidx(), lane = tid & 63, wid = tid >> 6, r32 = lane & 31, hi = lane >> 5;
    const bf16_t* qb = (const bf16_t*)(p.ws + OFF_RS + S_QB);
    const bf16_t* kb = (const bf16_t*)(p.ws + OFF_RS + S_KB);
    const bf16_t* vb = (const bf16_t*)(p.ws + OFF_RS + S_VB);
    float* af = (float*)(lds + SWA_AF) + wid * 32;
    float* bl = (float*)(lds + SWA_BIAS);
#pragma unroll
    for (int id = tid; id < 384 * 8; id += NTHR) {
        const int row = id >> 3, c = id & 7, pos = nblk * 128 - 128 + row;
        const bool ok = pos >= 0 && pos < S; const int pp = ok ? pos : 0;
        u32x4 kv = *(const u32x4*)(kb + (size_t)(b * S + pp) * 128 + g * 64 + c * 8), vv = *(const u32x4*)(vb + (size_t)(b * S + pp) * 128 + g * 64 + c * 8);
        if (!ok) { kv = (u32x4){0u, 0u, 0u, 0u}; vv = kv; }
        *(u32x4*)(lds + row * SWA_KROW + c * 16) = kv;
        *(u32x4*)(lds + SWA_KB + (c >> 2) * (384 * 64) + row * 64 + (c & 3) * 16) = vv;
    }
    {
        const float* bt = (const float*)(p.ws + OFF_MISC + M_BIAS);
#pragma unroll
        for (int id = tid; id < 4 * 512; id += NTHR) { const int hl = id >> 9, rel = (id & 511) - 255; bl[id] = (rel >= -128 && rel <= 128) ? bt[(g * 4 + hl) * 257 + rel + 128] : -INFINITY; }
    }
    __syncthreads();
    const int hl = wid >> 1, hh = g * 4 + hl;
    const float sinkv = p.l0_sinks[hh] * LOG2E;
    for (int sb = 0; sb < 2; ++sb) {
        const int qoff = (wid & 1) * 64 + sb * 32;
        const int qrow = b * S + nblk * 128 + qoff;
        bf16x8 qf[4];
        {
            const bf16_t* qp = qb + (size_t)(qrow + r32) * 512 + hh * 64 + hi * 8;
#pragma unroll
            for (int ks = 0; ks < 4; ++ks) qf[ks] = *(const bf16x8*)(qp + ks * 16);
        }
        float mrun = sinkv, lrun = hi == 0 ? 1.0f : 0.0f;
        f32x16 cinit;
#pragma unroll
        for (int r = 0; r < 16; ++r) cinit[r] = -sinkv;
        f32x16 o[2]; o[0] = (f32x16){}; o[1] = (f32x16){};
        const int qi = qoff + r32;
        for (int kt = 0; kt < 6; ++kt) {
            const int k0 = kt * 64;
            if (k0 - 128 - (qoff + 31) > 128 || k0 + 63 - 128 - qoff < -128) continue;
            if ((nblk == 0 && kt < 2) || (nblk == 63 && kt >= 4)) continue;
            f32x16 s0 = cinit, s1 = cinit;
#pragma unroll
            for (int ks = 0; ks < 4; ++ks) {
                const bf16x8 ka = *(const bf16x8*)(lds + (k0 + r32) * SWA_KROW + (ks * 2 + hi) * 16);
                const bf16x8 kb2 = *(const bf16x8*)(lds + (k0 + 32 + r32) * SWA_KROW + (ks * 2 + hi) * 16);
                s0 = MFMA32(ka, qf[ks], s0); s1 = MFMA32(kb2, qf[ks], s1);
            }
            {
                const float* bp = bl + hl * 512 + (k0 - 128 - qi + 4 * hi + 255);
#pragma unroll
                for (int r = 0; r < 16; ++r) { const int o_ = (r & 3) + 8 * (r >> 2); s0[r] += bp[o_]; s1[r] += bp[o_ + 32]; }
            }
            softmax_pv(s0, s1, mrun, lrun, o, cinit, false, lds + SWA_KB + k0 * 64, 384 * 64, af, lane);
        }
        bf16_t* dst = (bf16_t*)(p.ws + OFF_RS + S_CAT) + (size_t)qrow * 1024 + 512 + hh * 64;
        attn_store(o, lrun, af, dst, lane);
    }
    __syncthreads();
}
__device__ __forceinline__ void phase_attn(const Params& p, char* lds) {
    for (int u = blockIdx.x; u < 512 + 256; u += gridDim.x) {
        if (u < 512) {
            const int h = u & 7, qb = (u >> 3) & 31, b = u >> 8;
            if constexpr (MLA_V2) mla2::unit((const bf16_t*)p.out, (const bf16_t*)((const char*)p.out + 24 * MiB), (const bf16_t*)(p.ws + OFF_RS + S_V), (bf16_t*)(p.ws + OFF_RS + S_CAT), lds, b, h, qb);
            else mla_unit(p, lds, b, h, qb);
        }
        else { const int v = u - 512; const int g = v & 1, nblk = (v >> 1) & 63, b = v >> 7; swa_unit(p, lds, b, nblk, g); }
    }
}

struct EpiRes {
    static constexpr bool PERM = true;
    const bf16_t* res; bf16_t* dst;
    __device__ __forceinline__ void operator()(f32x4 (&acc)[2][2][4][2], const pg8::Unit& u, int wr, int wc, int fr, int fq) const {
#pragma unroll
        for (int ai = 0; ai < 2; ++ai) {
            u32x4 rr[4][2];
#pragma unroll
            for (int m = 0; m < 4; ++m)
#pragma unroll
                for (int bj = 0; bj < 2; ++bj) rr[m][bj] = *(const u32x4*)(res + (size_t)(u.pm * 256 + ai * 128 + wr * 64 + m * 16 + fr) * 1024 + u.pn * 256 + wc * 32 + fq * 8 + bj * 128);
#pragma unroll
            for (int m = 0; m < 4; ++m) {
                const size_t off = (size_t)(u.pm * 256 + ai * 128 + wr * 64 + m * 16 + fr) * 1024 + u.pn * 256 + wc * 32 + fq * 8;
#pragma unroll
                for (int bj = 0; bj < 2; ++bj) {
                    const size_t o = off + bj * 128; const u32x4 r = rr[m][bj]; const f32x4 a0 = acc[ai][bj][m][0], a1 = acc[ai][bj][m][1]; f32x4 v0, v1;
                    v0[0] = __uint_as_float(r.x << 16) * ALPHA + a0[0]; v0[1] = __uint_as_float(r.x & 0xffff0000u) * ALPHA + a0[1];
                    v0[2] = __uint_as_float(r.y << 16) * ALPHA + a0[2]; v0[3] = __uint_as_float(r.y & 0xffff0000u) * ALPHA + a0[3];
                    v1[0] = __uint_as_float(r.z << 16) * ALPHA + a1[0]; v1[1] = __uint_as_float(r.z & 0xffff0000u) * ALPHA + a1[1];
                    v1[2] = __uint_as_float(r.w << 16) * ALPHA + a1[2]; v1[3] = __uint_as_float(r.w & 0xffff0000u) * ALPHA + a1[3];
                    const u32x2 lo = pk4(v0), hi2 = pk4(v1);
                    *(u32x4*)(dst + o) = (u32x4){lo.x, lo.y, hi2.x, hi2.y};
                }
            }
        }
    }
};
__device__ __forceinline__ void phase_outproj(const Params& p, char* lds, const bf16_t* A, const bf16_t* Wt, const bf16_t* res, bf16_t* dst) {
    pg8::StaticOrder so; so.init(T, 1024, gridDim.x, blockIdx.x);
    EpiRes e{res, dst};
    pg8::gemm_phase(lds, A, Wt, 1024, so, pg8::DenseRows{}, e);
}

__device__ __forceinline__ void phase_ln_router(const Params& p, char* lds, const bf16_t* src, bf16_t* hb, const float* g, const float* bta, int layer) {
    const int tid = tidx(), lane = tid & 63, wid = tid >> 6, r16 = lane & 15, fq = lane >> 4;
    bf16_t* wbh = (bf16_t*)lds;
    bf16_t* wbl = (bf16_t*)(lds + 32768);
    float* gbl = (float*)(lds + 65536);
    int* lcnt = (int*)(lds + 73728);
    int* lbase = lcnt + 16;
    int* sel = lbase + 16;
    float* selw = (float*)(sel + 128);
    float* lgs = (float*)(lds + 73728 + 2048);
    {
        f32x4 rw[8];
#pragma unroll
        for (int k = 0; k < 8; ++k) rw[k] = *(const f32x4*)(p.router_w + (size_t)(tid + k * NTHR) * 4);
#pragma unroll
        for (int k = 0; k < 8; ++k) { const int i4 = tid + k * NTHR, kk = i4 >> 2, e0 = (i4 & 3) * 4;
            const int base = (((kk >> 5) * 4 + ((kk >> 3) & 3)) * 16) * 8 + (kk & 7);
#pragma unroll
            for (int j = 0; j < 4; ++j) { const float w = rw[k][j]; const bf16_t h = f2bf(w); wbh[base + (e0 + j) * 8] = h; wbl[base + (e0 + j) * 8] = f2bf(w - bf2f(h)); } }
        for (int i = tid; i < 256; i += NTHR) { *(f32x4*)(gbl + i * 4) = *(const f32x4*)(g + i * 4); *(f32x4*)(gbl + 1024 + i * 4) = *(const f32x4*)(bta + i * 4); }
    }
    if (tid < 16) lcnt[tid] = 0;
    __syncthreads();
    int* cnt = (int*)(p.ws + OFF_MISC + M_CNT) + layer * 16;
    int* list = (int*)(p.ws + OFF_MISC + M_LIST);
    float* gatew = (float*)(p.ws + OFF_MISC + M_GATEW);
    float* lgs2 = lgs + 1024;
    float2* part = (float2*)(lds + 73728 + 2048 + 8192);
    const int tg = __builtin_amdgcn_readfirstlane(wid & 3), kh = __builtin_amdgcn_readfirstlane(wid >> 2);
    for (int chunk = blockIdx.x; chunk < T / 64; chunk += gridDim.x) {
        {
            const int tl16 = tg * 16 + r16;
            const size_t tok = (size_t)(chunk * 64 + tl16);
            const bf16_t* rowp = src + tok * 1024 + kh * 512 + fq * 8;
            float sm = 0.f, sq = 0.f; f32x2 sm2 = {0.f, 0.f}, sq2 = {0.f, 0.f};
            u32x4 raw[16];
#pragma unroll
            for (int s_ = 0; s_ < 16; ++s_) raw[s_] = *(const u32x4*)(rowp + s_ * 32);
#pragma unroll
            for (int s_ = 0; s_ < 16; ++s_) {
                const u32x4 v = raw[s_];
#pragma unroll
                for (int j = 0; j < 4; ++j) { const f32x2 ab = {__uint_as_float(v[j] << 16), __uint_as_float(v[j] & 0xffff0000u)}; sm2 += ab; sq2 = __builtin_elementwise_fma(ab, ab, sq2); }
            }
            sm = sm2.x + sm2.y; sq = sq2.x + sq2.y;
            sm += __shfl_xor(sm, 16); sq += __shfl_xor(sq, 16); sm += __shfl_xor(sm, 32); sq += __shfl_xor(sq, 32);
            if (fq == 0) part[kh * 64 + tl16] = make_float2(sm, sq);
            __syncthreads();
            { const float2 p0 = part[tl16], p1 = part[64 + tl16]; sm = p0.x + p1.x; sq = p0.y + p1.y; }
            const float mu = sm * (1.0f / 1024.0f);
            const float rstd = rsqrtf(fmaxf(sq * (1.0f / 1024.0f) - mu * mu, 0.0f) + LN_EPS);
            const float nmr = -mu * rstd;
            f32x4 acc = (f32x4){0.f, 0.f, 0.f, 0.f};
            bf16_t* hrow = hb + tok * 1024 + kh * 512 + fq * 8;
#pragma unroll
            for (int s_ = 0; s_ < 16; ++s_) {
                const int sg = kh * 16 + s_;
                const u32x4 v = raw[s_];
                const f32x4 g0 = *(const f32x4*)(gbl + sg * 32 + fq * 8), g1 = *(const f32x4*)(gbl + sg * 32 + fq * 8 + 4);
                const f32x4 b0 = *(const f32x4*)(gbl + 1024 + sg * 32 + fq * 8), b1 = *(const f32x4*)(gbl + 1024 + sg * 32 + fq * 8 + 4);
                float y[8];
#pragma unroll
                for (int j = 0; j < 4; ++j) {
                    const float a = __uint_as_float(v[j] << 16), b = __uint_as_float(v[j] & 0xffff0000u);
                    const float ga = j < 2 ? g0[2 * j] : g1[2 * j - 4], gb2 = j < 2 ? g0[2 * j + 1] : g1[2 * j - 3];
                    const float ba = j < 2 ? b0[2 * j] : b1[2 * j - 4], bb2 = j < 2 ? b0[2 * j + 1] : b1[2 * j - 3];
                    y[2 * j] = __builtin_fmaf(__builtin_fmaf(a, rstd, nmr), ga, ba); y[2 * j + 1] = __builtin_fmaf(__builtin_fmaf(b, rstd, nmr), gb2, bb2);
                }
                u32x4 hi, lo;
#pragma unroll
                for (int j = 0; j < 4; ++j) {
                    hi[j] = pk2(y[2 * j], y[2 * j + 1]);
                    lo[j] = pk2(y[2 * j] - __uint_as_float(hi[j] << 16), y[2 * j + 1] - __uint_as_float(hi[j] & 0xffff0000u));
                }
                *(u32x4*)(hrow + s_ * 32) = hi;
                const bf16x8 bh = *(const bf16x8*)(wbh + ((sg * 4 + fq) * 16 + r16) * 8), bl = *(const bf16x8*)(wbl + ((sg * 4 + fq) * 16 + r16) * 8);
                const bf16x8 ah = __builtin_bit_cast(bf16x8, hi), al = __builtin_bit_cast(bf16x8, lo);
                acc = MFMA16(bh, ah, acc); acc = MFMA16(bh, al, acc); acc = MFMA16(bl, ah, acc);
            }
            *(f32x4*)((kh ? lgs2 : lgs) + tl16 * 16 + fq * 4) = acc;
        }
        __syncthreads();
        {
            const int tl = wid * 8 + (lane >> 3);
            float lg[16];
#pragma unroll
            for (int e4 = 0; e4 < 4; ++e4) { const f32x4 t4 = *(const f32x4*)(lgs + tl * 16 + e4 * 4) + *(const f32x4*)(lgs2 + tl * 16 + e4 * 4); lg[e4 * 4] = t4[0]; lg[e4 * 4 + 1] = t4[1]; lg[e4 * 4 + 2] = t4[2]; lg[e4 * 4 + 3] = t4[3]; }
            float sc[16], bs[16];
#pragma unroll
            for (int e = 0; e < 16; ++e) { sc[e] = fsigmoid(lg[e]); bs[e] = sc[e] + p.router_bias[e]; }
            int gsel = 0; float gbest = -INFINITY;
#pragma unroll
            for (int gq = 0; gq < 4; ++gq) {
                float m1 = -INFINITY, m2 = -INFINITY;
#pragma unroll
                for (int e = 0; e < 4; ++e) { const float x = bs[gq * 4 + e]; m2 = fmaxf(m2, fminf(x, m1)); m1 = fmaxf(m1, x); }
                const float gs = m1 + m2;
                if (gs > gbest) { gbest = gs; gsel = gq; }
            }
            float b0 = -INFINITY, b1 = -INFINITY, w0 = 0.f, w1 = 0.f; int e0 = 0, e1 = 0;
#pragma unroll
            for (int e = 0; e < 16; ++e) {
                const float x = (e >> 2) == gsel ? bs[e] : -INFINITY;
                const bool c0 = x > b0, c1 = x > b1;
                b1 = c0 ? b0 : (c1 ? x : b1); e1 = c0 ? e0 : (c1 ? e : e1); w1 = c0 ? w0 : (c1 ? sc[e] : w1);
                b0 = c0 ? x : b0; e0 = c0 ? e : e0; w0 = c0 ? sc[e] : w0;
            }
            const float inv = 1.0f / (w0 + w1);
            if ((lane & 7) == 0) {
                const int l0 = atomicAdd(&lcnt[e0], 1), l1 = atomicAdd(&lcnt[e1], 1);
                sel[tl * 2] = e0 | (l0 << 8); sel[tl * 2 + 1] = e1 | (l1 << 8);
                selw[tl * 2] = w0 * inv; selw[tl * 2 + 1] = w1 * inv;
            }
        }
        __syncthreads();
        if (tid < 16) lbase[tid] = atomicAdd(&cnt[tid], lcnt[tid]);
        __syncthreads();
        if (tid < 128) {
            const int sv = sel[tid], e = sv & 255, lp = sv >> 8, tk = (chunk * 64 + (tid >> 1)) * 2 + (tid & 1);
            list[e * T + lbase[e] + lp] = tk;
            gatew[tk] = selw[tid];
        }
        __syncthreads();
        if (tid < 16) lcnt[tid] = 0;
        __syncthreads();
    }
}

constexpr size_t M_READY = 1024;
struct MoeOrder {
    typedef int i32x2 __attribute__((ext_vector_type(2)));
    typedef __attribute__((address_space(3))) i32x2 LdsInt2;
    const int* list; int* ready; int G, c, nmt  , nsmall  ; bool down; mutable int pend; const LdsInt2* tab;
    __device__ void init(char* lds, const int* cnt_, const int* list_, int* ready_, int G_, int c_, bool down_) {
        list = list_; ready = ready_; G = G_; c = c_; down = down_; pend = -1;
        typedef __attribute__((address_space(3))) int LdsInt;
        LdsInt2* tb = (LdsInt2*)(__attribute__((address_space(3))) char*)(lds + LDS_MTAB); LdsInt* cn = (LdsInt*)(__attribute__((address_space(3))) char*)(lds + LDS_MTAB + 160 * 8);
        tab = tb;
        const int tid = tidx();
        __syncthreads();
        if (tid < 16) cn[tid] = cnt_[tid];
        __syncthreads();
        int n = 0, me = -1, mr0 = 0, mv = 0;
#pragma unroll
        for (int e = 0; e < 16; ++e) {
            const int cv = cn[e], ne = (cv + 255) >> 8;
            if (tid >= n && tid < n + ne) { me = e; mr0 = (tid - n) * 256; mv = min(256, cv - mr0); }
            n += ne;
        }
        if (tid < 16) {
            const int ce = cn[tid], lv = ce > 0 ? ((ce - 1) & 255) + 1 : 0; const bool part = lv > 0 && lv < 256;
            int rk = 0, P = 0;
#pragma unroll
            for (int e2 = 0; e2 < 16; ++e2) { const int c2 = cn[e2], l2 = c2 > 0 ? ((c2 - 1) & 255) + 1 : 0; const bool p2 = l2 > 0 && l2 < 256; P += p2 ? 1 : 0; rk += (p2 && (l2 < lv || (l2 == lv && e2 < tid))) ? 1 : 0; }
            int Sp = n % (G_ / 4 > 0 ? G_ / 4 : 1); if (Sp > 16) Sp = 0; if (Sp > P) Sp = P;
            cn[32 + tid] = (part && rk < Sp) ? rk : -1;
            if (tid == 0) { cn[31] = Sp; cn[30] = n - Sp; }
        }
        __syncthreads();
        {
            const int Sp = cn[31];
            int smallBefore = 0, myrk = -1;
#pragma unroll
            for (int e2 = 0; e2 < 16; ++e2) { const int r2 = cn[32 + e2]; smallBefore += (e2 < me && r2 >= 0) ? 1 : 0; myrk = (e2 == me) ? r2 : myrk; }
            const bool have = me >= 0 && tid < 160, mylast = have && (mr0 + 256 >= cn[me < 0 ? 0 : me]), mysmall = mylast && myrk >= 0;
            nsmall = __builtin_amdgcn_readfirstlane(Sp); nmt = __builtin_amdgcn_readfirstlane(n - Sp);
            if (have) { i32x2 en; en.x = me * T + mr0; en.y = me | (mv << 8); tb[mysmall ? (n - Sp) + myrk : tid - smallBefore] = en; }
        }
        __syncthreads();
    }
    __device__ void attach(char* lds, const int* list_, int* ready_, int G_, int c_) {
        list = list_; ready = ready_; G = G_; c = c_; down = false; pend = -1;
        typedef __attribute__((address_space(3))) int LdsInt;
        tab = (LdsInt2*)(__attribute__((address_space(3))) char*)(lds + LDS_MTAB);
        const LdsInt* cn = (const LdsInt*)(__attribute__((address_space(3))) char*)(lds + LDS_MTAB + 160 * 8);
        nmt = __builtin_amdgcn_readfirstlane(cn[30]); nsmall = __builtin_amdgcn_readfirstlane(cn[31]);
    }
    __device__ bool next(int i, pg8::Unit& u) const {
        const int nwg = nmt * 4; long L = (long)i * G + c;
        if (down) {
            const int nf = nwg / G, r = nwg - nf * G;
            if (nf == 2 && r > 0 && 3 * r <= G) {
                if (c >= r) L = i == 0 ? c - r : (i == 1 ? (G - r) + (c - r) : ((i == 2 && c < 3 * r) ? 2 * (G - r) + r + (c - r) : nwg));
                else L = i == 0 ? 2 * (G - r) + c : nwg;
            }
        }
        if (L >= nwg) return false;
        int wgid = (int)L; { const int q = nwg / 8, r = nwg % 8, xcd = wgid % 8, off = wgid / 8; wgid = (xcd < r ? xcd * (q + 1) : r * (q + 1) + (xcd - r) * q) + off; }
        const int mtile = wgid >> 2;
        const i32x2 en = tab[mtile];
        const int ex = __builtin_amdgcn_readfirstlane(en.x), ey = __builtin_amdgcn_readfirstlane(en.y);
        u.pm = mtile; u.e = ey & 255; u.pn = u.e * 4 + (wgid & 3); u.valid = ey >> 8; u.lst = list + ex;
        return true;
    }
    __device__ __forceinline__ void a_ready(const pg8::Unit& u) const {
        if (!down) return;
        if (threadIdx.x < 64) {
            unsigned sp = 0;
            while (__builtin_amdgcn_readfirstlane(__hip_atomic_load(ready + u.pm, __ATOMIC_RELAXED, __HIP_MEMORY_SCOPE_AGENT)) < 32) {
                __builtin_amdgcn_s_sleep(2);
                if (++sp > (1u << 22)) break;
            }
            __builtin_amdgcn_fence(__ATOMIC_ACQUIRE, "agent");
            asm volatile("s_waitcnt vmcnt(0)" ::: "memory");
        }
        asm volatile("" ::: "memory"); __builtin_amdgcn_s_barrier(); asm volatile("" ::: "memory");
    }
    __device__ __forceinline__ void done(const pg8::Unit& u) const {
        if (down) return;
        asm volatile("s_waitcnt vmcnt(0)" ::: "memory");
        if ((threadIdx.x & 63) == 0) __hip_atomic_fetch_add(ready + u.pm, 1, __ATOMIC_RELAXED, __HIP_MEMORY_SCOPE_AGENT);
    }
};
struct GatherRows { int sh; __device__ __forceinline__ unsigned rowoff(const pg8::Unit& u, int row, int K) const { return (unsigned)(u.lst[min(row, u.valid - 1)] >> sh) * (unsigned)K * 2u; } };
constexpr bool MOE_MERGED = false;
struct EpiMoeUp {
    static constexpr bool PERM = true;
    bf16_t* H;
    __device__ __forceinline__ void operator()(f32x4 (&acc)[2][2][4][2], const pg8::Unit& u, int wr, int wc, int fr, int fq) const {
        const int pnl = u.pn & 3;
        int tks[2][4];
#pragma unroll
        for (int ai = 0; ai < 2; ++ai)
#pragma unroll
            for (int m = 0; m < 4; ++m) tks[ai][m] = u.lst[min(ai * 128 + wr * 64 + m * 16 + fr, u.valid - 1)];
#pragma unroll
        for (int ai = 0; ai < 2; ++ai)
#pragma unroll
            for (int m = 0; m < 4; ++m) {
                const int r = ai * 128 + wr * 64 + m * 16 + fr;
                if (r < u.valid) {
                    const int tk = tks[ai][m];
                    f32x4 o0, o1;
#pragma unroll
                    for (int k = 0; k < 4; ++k) { const float a = acc[ai][0][m][0][k], b = acc[ai][0][m][1][k]; o0[k] = a * fsigmoid(a) * b; }
#pragma unroll
                    for (int k = 0; k < 4; ++k) { const float a = acc[ai][1][m][0][k], b = acc[ai][1][m][1][k]; o1[k] = a * fsigmoid(a) * b; }
                    const u32x2 lo = pk4(o0), hi2 = pk4(o1);
                    {
                        const unsigned long long ha = (unsigned long long)(H + (size_t)tk * 512 + ((pnl * 4 + wc) * 4 + fq) * 8);
                        const u32x4 hv = (u32x4){lo.x, lo.y, hi2.x, hi2.y};
                        if constexpr (MOE_MERGED) asm volatile("global_store_dwordx4 %0, %1, off sc1" :: "v"(ha), "v"(hv) : "memory"); else *(u32x4*)ha = hv;
                    }
                }
            }
    }
};
struct EpiMoeDn {
    static constexpr bool PERM = true;
    bf16_t* Y; const float* gw;
    __device__ __forceinline__ void operator()(f32x4 (&acc)[2][2][4][2], const pg8::Unit& u, int wr, int wc, int fr, int fq) const {
        const int pnl = u.pn & 3;
        int tks[2][4]; float gts[2][4];
#pragma unroll
        for (int ai = 0; ai < 2; ++ai)
#pragma unroll
            for (int m = 0; m < 4; ++m) tks[ai][m] = u.lst[min(ai * 128 + wr * 64 + m * 16 + fr, u.valid - 1)];
#pragma unroll
        for (int ai = 0; ai < 2; ++ai)
#pragma unroll
            for (int m = 0; m < 4; ++m) gts[ai][m] = gw[tks[ai][m]];
#pragma unroll
        for (int ai = 0; ai < 2; ++ai)
#pragma unroll
            for (int m = 0; m < 4; ++m) {
                const int r = ai * 128 + wr * 64 + m * 16 + fr;
                if (r < u.valid) {
                    const int tk = tks[ai][m]; const float gt = gts[ai][m];
                    bf16_t* dst = Y + (size_t)tk * 1024 + pnl * 256 + wc * 32 + fq * 8;
#pragma unroll
                    for (int bj = 0; bj < 2; ++bj) { const u32x2 lo = pk4(acc[ai][bj][m][0] * gt), hi2 = pk4(acc[ai][bj][m][1] * gt); *(u32x4*)(dst + bj * 128) = (u32x4){lo.x, lo.y, hi2.x, hi2.y}; }
                }
            }
    }
};
template <int WHICH>
__device__ __forceinline__ void moe_small(const Params& p, char* lds) {
    constexpr int K = WHICH == 0 ? 1024 : 512, PITCH = 528, XB = 0, WB = 128 * PITCH;
    const int tid = tidx(), lane = tid & 63, wv = tid >> 6, fr = lane & 15, fq = lane >> 4, c16 = tid & 31, r0 = tid >> 5;
#define L3 __attribute__((address_space(3)))
    L3 char* l3 = (L3 char*)lds;
#define G1 __attribute__((address_space(1)))
    char* wsl = p.ws; asm volatile("" : "+s"(wsl));
    G1 char* wsb = (G1 char*)wsl;
    const G1 bf16_t* ra = (const G1 bf16_t*)(wsb + OFF_RA); G1 bf16_t* Hm = (G1 bf16_t*)(wsb + OFF_RS + S_HMOE); G1 bf16_t* Y = (G1 bf16_t*)(wsb + OFF_RS + S_Y);
    const G1 float* gw = (const G1 float*)(wsb + OFF_MISC + M_GATEW);
    typedef __attribute__((address_space(3))) int LdsInt;
    const MoeOrder::LdsInt2* tabl = (const MoeOrder::LdsInt2*)(__attribute__((address_space(3))) char*)(lds + LDS_MTAB);
    const LdsInt* cnl = (const LdsInt*)(__attribute__((address_space(3))) char*)(lds + LDS_MTAB + 160 * 8);
    const int nbig = __builtin_amdgcn_readfirstlane(cnl[30]), nsu = __builtin_amdgcn_readfirstlane(cnl[31]) * 32;
    const G1 int* listp = (const G1 int*)(wsb + OFF_MISC + M_LIST);
    for (int su = blockIdx.x; su < nsu; su += gridDim.x) {
        const MoeOrder::i32x2 en = tabl[nbig + (su >> 5)];
        const int ey = __builtin_amdgcn_readfirstlane(en.y), e = ey & 255, rb = ((su >> 4) & 1) * 128, valid = (ey >> 8) - rb, sl = su & 15;
        if (valid <= 0) continue;
        const int ex = __builtin_amdgcn_readfirstlane(en.x) + rb;
        int tks[8];
#pragma unroll
        for (int i = 0; i < 8; ++i) tks[i] = listp[ex + min(r0 + 16 * i, valid - 1)];
        const int mytk = listp[ex + min(wv * 16 + fr, valid - 1)];
        const G1 bf16_t* xs[8]; const G1 bf16_t* ws_[4];
#pragma unroll
        for (int i = 0; i < 8; ++i) xs[i] = (WHICH == 0 ? ra + (size_t)(tks[i] >> 1) * 1024 : Hm + (size_t)tks[i] * 512) + c16 * 8;
#pragma unroll
        for (int i = 0; i < 4; ++i) {
            const int wr_ = r0 + 16 * i;
            if constexpr (WHICH == 0) ws_[i] = (const G1 bf16_t*)(wsb + OFF_WMOE + W_UP) + (size_t)e * (1024 * 1024) + (size_t)(nmap(3, sl * 32 + (wr_ & 31)) + (wr_ >> 5) * 4) * 1024 + c16 * 8;
            else ws_[i] = (const G1 bf16_t*)(wsb + OFF_WMOE + W_DN) + (size_t)e * (1024 * 512) + (size_t)(sl * 64 + wr_) * 512 + c16 * 8;
        }
        f32x4 acc[4];
#pragma unroll
        for (int f = 0; f < 4; ++f) acc[f] = (f32x4){0.f, 0.f, 0.f, 0.f};
        constexpr int NCH = K / 256;
        u32x4 xr[2][8], wr4[2][4];
#pragma unroll
        for (int cb = 0; cb < 2; ++cb) {
#pragma unroll
            for (int i = 0; i < 4; ++i) wr4[cb][i] = *(const G1 u32x4*)(ws_[i] + cb * 256);
#pragma unroll
            for (int i = 0; i < 8; ++i) xr[cb][i] = *(const G1 u32x4*)(xs[i] + cb * 256);
        }
#pragma unroll
        for (int ch = 0; ch < NCH; ++ch) {
            __syncthreads();
#pragma unroll
            for (int i = 0; i < 8; ++i) *(L3 u32x4*)(l3 + XB + (r0 + 16 * i) * PITCH + c16 * 16) = xr[ch & 1][i];
#pragma unroll
            for (int i = 0; i < 4; ++i) *(L3 u32x4*)(l3 + WB + (r0 + 16 * i) * PITCH + c16 * 16) = wr4[ch & 1][i];
            if (ch + 2 < NCH) {
#pragma unroll
                for (int i = 0; i < 4; ++i) wr4[ch & 1][i] = *(const G1 u32x4*)(ws_[i] + (ch + 2) * 256);
#pragma unroll
                for (int i = 0; i < 8; ++i) xr[ch & 1][i] = *(const G1 u32x4*)(xs[i] + (ch + 2) * 256);
            }
            __syncthreads();
#pragma unroll
            for (int s_ = 0; s_ < 8; ++s_) {
                const bf16x8 xf = *(const L3 bf16x8*)(l3 + XB + (wv * 16 + fr) * PITCH + s_ * 64 + fq * 16);
#pragma unroll
                for (int f = 0; f < 4; ++f) {
                    const bf16x8 wf = *(const L3 bf16x8*)(l3 + WB + (f * 16 + fr) * PITCH + s_ * 64 + fq * 16);
                    acc[f] = MFMA16(wf, xf, acc[f]);
                }
            }
        }
        if (wv * 16 + fr < valid) {
            if constexpr (WHICH == 0) {
#pragma unroll
                for (int f = 0; f < 2; ++f) {
                    f32x4 o;
#pragma unroll
                    for (int k = 0; k < 4; ++k) o[k] = acc[f][k] * fsigmoid(acc[f][k]) * acc[2 + f][k];
                    *(G1 u32x2*)(Hm + (size_t)mytk * 512 + sl * 32 + f * 16 + fq * 4) = pk4(o);
                }
            } else {
                const float gt = gw[mytk];
#pragma unroll
                for (int f = 0; f < 4; ++f) *(G1 u32x2*)(Y + (size_t)mytk * 1024 + sl * 64 + f * 16 + fq * 4) = pk4(acc[f] * gt);
            }
        }
        __syncthreads();
    }
}
#undef L3
#undef G1
__device__ __forceinline__ void phase_moe(const Params& p, char* lds, int layer, int which) {
    const int* cnt = (const int*)(p.ws + OFF_MISC + M_CNT) + layer * 16; const int* list = (const int*)(p.ws + OFF_MISC + M_LIST);
    int* ready = (int*)(p.ws + OFF_MISC + M_READY) + layer * 160;
    MoeOrder mo;
    if (which == 0) mo.init(lds, cnt, list, ready, gridDim.x, blockIdx.x, false); else mo.attach(lds, list, ready, gridDim.x, blockIdx.x);
    if (which == 0) {
        EpiMoeUp e{(bf16_t*)(p.ws + OFF_RS + S_HMOE)};
        pg8::gemm_phase<false>(lds, (const bf16_t*)(p.ws + OFF_RA), (const bf16_t*)(p.ws + OFF_WMOE + W_UP), 1024, mo, GatherRows{1}, e);
        moe_small<0>(p, lds);
    } else {
        EpiMoeDn e{(bf16_t*)(p.ws + OFF_RS + S_Y), (const float*)(p.ws + OFF_MISC + M_GATEW)};
        pg8::gemm_phase<false>(lds, (const bf16_t*)(p.ws + OFF_RS + S_HMOE), (const bf16_t*)(p.ws + OFF_WMOE + W_DN), 512, mo, GatherRows{0}, e);
        moe_small<1>(p, lds);
    }
}
struct Ln2Row { u32x4 h[2], y0[2], y1[2]; };
__device__ __forceinline__ void ln2_load(Ln2Row& r, const bf16_t* hb, const bf16_t* Y, int tok, int lane) {
#pragma unroll
    for (int i = 0; i < 2; ++i) {
        const int c = (i * 64 + lane) * 8;
        r.h[i] = *(const u32x4*)(hb + (size_t)tok * 1024 + c);
        r.y0[i] = *(const u32x4*)(Y + (size_t)(2 * tok) * 1024 + c);
        r.y1[i] = *(const u32x4*)(Y + (size_t)(2 * tok + 1) * 1024 + c);
    }
}
__device__ __forceinline__ void phase_ln2(const Params& p, const bf16_t* hb, float* dstf, bf16_t* dstb, const float* g, const float* bta) {
    const int lane = tidx() & 63, wid = __builtin_amdgcn_readfirstlane(tidx() >> 6);
    const bf16_t* Y = (const bf16_t*)(p.ws + OFF_RS + S_Y);
    f32x2 gv[2][4], bv[2][4];
#pragma unroll
    for (int i = 0; i < 2; ++i)
#pragma unroll
        for (int j = 0; j < 4; ++j) { const int c = (i * 64 + lane) * 8 + 2 * j; gv[i][j] = *(const f32x2*)(g + c); bv[i][j] = *(const f32x2*)(bta + c); }
    auto row = [&](const Ln2Row& cur, int tok) __attribute__((always_inline)) {
        f32x2 v[2][4];
        f32x2 s2 = {0.f, 0.f};
#pragma unroll
        for (int i = 0; i < 2; ++i)
#pragma unroll
            for (int j = 0; j < 4; ++j) {
                const unsigned hr = cur.h[i][j], a0 = cur.y0[i][j], a1 = cur.y1[i][j];
                const f32x2 h = {__uint_as_float(hr << 16), __uint_as_float(hr & 0xffff0000u)};
                const f32x2 ya = {__uint_as_float(a0 << 16), __uint_as_float(a0 & 0xffff0000u)}, yb = {__uint_as_float(a1 << 16), __uint_as_float(a1 & 0xffff0000u)};
                v[i][j] = __builtin_elementwise_fma(h, (f32x2){ALPHA, ALPHA}, ya + yb);
                s2 += v[i][j];
            }
        const float mu = wave_sum(s2.x + s2.y) * (1.0f / 1024.0f);
        f32x2 q2 = {0.f, 0.f};
#pragma unroll
        for (int i = 0; i < 2; ++i)
#pragma unroll
            for (int j = 0; j < 4; ++j) { v[i][j] = v[i][j] - (f32x2){mu, mu}; q2 = __builtin_elementwise_fma(v[i][j], v[i][j], q2); }
        const float rstd = rsqrtf(wave_sum(q2.x + q2.y) * (1.0f / 1024.0f) + LN_EPS);
#pragma unroll
        for (int i = 0; i < 2; ++i) {
            const int c = (i * 64 + lane) * 8;
            f32x2 o[4];
#pragma unroll
            for (int j = 0; j < 4; ++j) o[j] = __builtin_elementwise_fma(v[i][j] * (f32x2){rstd, rstd}, gv[i][j], bv[i][j]);
            if (dstf) {
                *(f32x4*)(dstf + (size_t)tok * 1024 + c) = (f32x4){o[0].x, o[0].y, o[1].x, o[1].y};
                *(f32x4*)(dstf + (size_t)tok * 1024 + c + 4) = (f32x4){o[2].x, o[2].y, o[3].x, o[3].y};
            }
            if (dstb) *(u32x4*)(dstb + (size_t)tok * 1024 + c) = (u32x4){pk2(o[0].x, o[0].y), pk2(o[1].x, o[1].y), pk2(o[2].x, o[2].y), pk2(o[3].x, o[3].y)};
        }
    };
    const int stride = gridDim.x * 8;
    int tok = blockIdx.x * 8 + wid;
    Ln2Row ra, rb;
    if (tok < T) ln2_load(ra, hb, Y, tok, lane);
    while (tok < T) {
        ln2_load(rb, hb, Y, tok + stride < T ? tok + stride : tok, lane);
        __builtin_amdgcn_sched_barrier(0);
        row(ra, tok);
        tok += stride;
        if (tok >= T) break;
        ln2_load(ra, hb, Y, tok + stride < T ? tok + stride : tok, lane);
        __builtin_amdgcn_sched_barrier(0);
        row(rb, tok);
        tok += stride;
    }
}

struct EpiIn1 {
    static constexpr bool PERM = true;
    const Params& p;
    __device__ __forceinline__ void operator()(f32x4 (&acc)[2][2][4][2], const pg8::Unit& u, int wr, int wc, int fr, int fq) const {
        bf16_t* gg = (bf16_t*)(p.ws + OFF_RS + S_GG);
        bf16_t* xr = (bf16_t*)(p.ws + OFF_RS + S_XR);
#pragma unroll
        for (int ai = 0; ai < 2; ++ai)
#pragma unroll
            for (int m = 0; m < 4; ++m) {
                const int row = u.pm * 256 + ai * 128 + wr * 64 + m * 16 + fr;
#pragma unroll
                for (int bj = 0; bj < 2; ++bj) {
                    const int seg = 2 * u.pn + bj;
                    f32x4 v0 = acc[ai][bj][m][0], v1 = acc[ai][bj][m][1];
                    bf16_t* dst;
                    if (seg < 8) {
                        dst = gg + (size_t)row * 1024 + seg * 128 + wc * 32 + fq * 8;
#pragma unroll
                        for (int k = 0; k < 4; ++k) { v0[k] = gelu_tanh(v0[k]); v1[k] = gelu_tanh(v1[k]); }
                    } else dst = xr + (size_t)row * 1024 + (seg - 8) * 128 + wc * 32 + fq * 8;
                    const u32x2 lo = pk4(v0), hi2 = pk4(v1);
                    *(u32x4*)dst = (u32x4){lo.x, lo.y, hi2.x, hi2.y};
                }
            }
    }
};
__device__ __forceinline__ void phase_in1(const Params& p, char* lds) {
    pg8::StaticOrder so; so.init(T, 2048, gridDim.x, blockIdx.x);
    EpiIn1 e{p};
    pg8::gemm_phase(lds, (const bf16_t*)(p.ws + OFF_RA), (const bf16_t*)(p.ws + OFF_WS + W_IN1), 1024, so, pg8::DenseRows{}, e);
}
constexpr int LC = 64, NCH = S / LC;
constexpr int SC_XC = 0, SC_GI = 32768;
__device__ __forceinline__ float lam_c(float lam) { return -8.0f * log1pf(expf(-lam)); }
__device__ __forceinline__ void lru_ab(float c8, float r, float ix, float& a, float& b) {
    const float la = c8 * r; a = __expf(la); b = sqrtf(fmaxf(1.0f - a * a, 0.0f)) * ix;
}
constexpr int BG_TILES = 3 * 2048;
struct BgLane { unsigned sA, sB, dA, dB; };
__device__ __forceinline__ BgLane bg_lane(int tid) {
    const int wv = tid >> 6, lane = tid & 63, nl = (wv & 3) * 16 + (lane & 15), kl = (wv >> 2) * 32 + (lane >> 4) * 8;
    BgLane L;
    L.sA = (unsigned)(kl * 512 + nl); L.sB = (unsigned)(kl * 1024 + nl);
    L.dA = (unsigned)((128 * ((nl >> 2) & 1) + 32 * (nl >> 5) + 8 * ((nl >> 3) & 3) + (nl & 3)) * 1024 + kl);
    L.dB = (unsigned)(nl * 512 + kl);
    return L;
}
struct BgTile { const float* src; bf16_t* dst; unsigned so, d_o; int N; };
__device__ __forceinline__ BgTile bg_tile(const Params& p, int t, const BgLane& L) {
    t = t < BG_TILES ? t : BG_TILES - 1;
    const int mat = t >> 11, r = t & 2047, e = r >> 7, q = r & 127;
    bf16_t* w = (bf16_t*)(p.ws + OFF_WMOE);
    BgTile b;
    if (mat < 2) {
        const int kt = q >> 3, nt = q & 7;
        b.N = 512; b.src = (mat == 0 ? p.l1_w1 : p.l1_w3) + (size_t)e * (1024 * 512) + (size_t)(kt * 64) * 512 + nt * 64;
        b.dst = w + W_UP / 2 + (size_t)e * (1024 * 1024) + (size_t)(256 * (nt >> 1) + 64 * (nt & 1) + 4 * mat) * 1024 + kt * 64;
        b.so = L.sA; b.d_o = L.dA;
    } else {
        const int kt = q >> 4, nt = q & 15;
        b.N = 1024; b.src = p.l1_w2 + (size_t)e * (512 * 1024) + (size_t)(kt * 64) * 1024 + nt * 64;
        b.dst = w + W_DN / 2 + (size_t)e * (1024 * 512) + (size_t)(nt * 64) * 512 + kt * 64;
        b.so = L.sB; b.d_o = L.dB;
    }
    return b;
}
__device__ __forceinline__ void bg_load(const BgTile& b, float (&v)[8]) {
#pragma unroll
    for (int j = 0; j < 8; ++j) v[j] = __builtin_nontemporal_load(b.src + b.so + (unsigned)(j * b.N));
}
__device__ __forceinline__ void bg_store(const BgTile& b, const float (&v)[8]) {
    *(u32x4*)(b.dst + b.d_o) = (u32x4){pk2(v[0], v[1]), pk2(v[2], v[3]), pk2(v[4], v[5]), pk2(v[6], v[7])};
}
struct ScanPre { u32x4 v[2][4]; unsigned ok; float car; };
template <int PASS>
__device__ __forceinline__ void scan_prefetch(ScanPre& pre, const Params& p, const bf16_t* xr, int it, int tid) {
    const int blk = it & 7, cc = it >> 3, c = cc & (NCH - 1), b = cc >> 7, cq = tid & 15;
    const int row0 = b * S + c * LC, ch0 = blk * 128;
    unsigned okm = 0u;
#pragma unroll
    for (int i = 0; i < 2; ++i) {
        const int t = (tid >> 4) + 32 * i, sp = c * LC + t;
#pragma unroll
        for (int k = 0; k < 4; ++k) {
            const int ss = sp + k - 2; const bool ok = ss >= 0 && ss < S;
            const int rr = ok ? row0 + t + k - 2 : row0 + t;
            pre.v[i][k] = *(const u32x4*)(xr + (size_t)rr * 1024 + ch0 + cq * 8);
            okm |= (ok ? 1u : 0u) << (i * 4 + k);
        }
    }
    pre.ok = okm;
    if constexpr (PASS == 2) {
        const float* car = (const float*)(p.ws + OFF_RS + ((tid & 128) ? S_CARB : S_CARF));
        pre.car = car[(size_t)(b * NCH + c) * 1024 + ch0 + (tid & 127)];
    }
}
constexpr int REP_GEMM = 1, REP_SCAN = 1;
constexpr int SC_CONST = SC_GI + 65536;
template <int PASS>
__device__ __forceinline__ void phase_scan(const Params& p, char* lds) {
    const int tid = tidx(), lane = tid & 63, wid = tid >> 6, fr = lane & 15, fq = lane >> 4;
    const bf16_t* xr = (const bf16_t*)(p.ws + OFF_RS + S_XR);
    const bf16_t* gg = (const bf16_t*)(p.ws + OFF_RS + S_GG);
    const bf16_t* wg = (const bf16_t*)(p.ws + OFF_WS + W_GATE);
    float2* aggF = (float2*)(p.ws + OFF_RS + S_AGGF); float2* aggB = (float2*)(p.ws + OFF_RS + S_AGGB);
    bf16_t* yb = (bf16_t*)(p.ws + OFF_RS + S_XC);
    float* cst = (float*)(lds + SC_CONST);
    const int d = __builtin_amdgcn_readfirstlane(wid >> 2), q = __builtin_amdgcn_readfirstlane(wid & 3);
    bf16x8 wf[4][4];
    int cur_blk = -1;
    const int nitems = 2 * NCH * 8;
    ScanPre pre; pre.car = 0.f; pre.ok = 0u;
    int xsel = 0;
    const BgLane bgl = bg_lane(tid);
    for (int it = blockIdx.x; it < nitems; it += gridDim.x) {
        const int blk = it & 7, cc = it >> 3, c = cc & (NCH - 1), b = cc >> 7;
        const int row0 = b * S + c * LC, ch0 = blk * 128;
        char* xcb = lds + SC_XC + xsel * 16384; xsel ^= 1;
        if (blk != cur_blk) {
            cur_blk = blk;
#pragma unroll
            for (int n = 0; n < 4; ++n) {
                const bf16_t* wrow = wg + ((size_t)((2 * d + (n >> 1)) * 8 + blk) * 128 + q * 32 + (n & 1) * 16 + fr) * 128 + fq * 8;
#pragma unroll
                for (int kk = 0; kk < 4; ++kk) wf[n][kk] = *(const bf16x8*)(wrow + kk * 32);
            }
            {
                float cv[3];
#pragma unroll
                for (int k = 0; k < 3; ++k) {
                    const int i = tid + k * NTHR, j = __builtin_amdgcn_readfirstlane(i < 11 * 128 ? i >> 7 : 10);
                    const float* sp = j < 4 ? p.l1_conv_w + j * 1024 : j == 4 ? p.l1_conv_b : j == 5 ? p.l1_ba_f : j == 6 ? p.l1_bx_f : j == 7 ? p.l1_ba_b : j == 8 ? p.l1_bx_b : j == 9 ? p.l1_lam_f : p.l1_lam_b;
                    cv[k] = sp[ch0 + (i & 127)];
                }
#pragma unroll
                for (int k = 0; k < 3; ++k) {
                    const int i = tid + k * NTHR, j = i >> 7;
                    if (i < 11 * 128) cst[i] = j < 5 ? cv[k] : (j < 9 ? -LOG2E * cv[k] : lam_c(cv[k]) * LOG2E);
                }
            }
            scan_prefetch<PASS>(pre, p, xr, it, tid);
            __syncthreads();
        }
        {
            const int cq = tid & 15;
            if (c == 0 || c == NCH - 1) {
#pragma unroll
                for (int i = 0; i < 2; ++i)
#pragma unroll
                    for (int k = 0; k < 4; ++k)
                        if (!((pre.ok >> (i * 4 + k)) & 1u)) pre.v[i][k] = (u32x4){0u, 0u, 0u, 0u};
            }
            f32x2 a[2][4];
            {
                const f32x4 b0 = *(const f32x4*)(cst + 4 * 128 + cq * 8), b1 = *(const f32x4*)(cst + 4 * 128 + cq * 8 + 4);
#pragma unroll
                for (int i = 0; i < 2; ++i) { a[i][0] = (f32x2){b0[0], b0[1]}; a[i][1] = (f32x2){b0[2], b0[3]}; a[i][2] = (f32x2){b1[0], b1[1]}; a[i][3] = (f32x2){b1[2], b1[3]}; }
            }
#pragma unroll
            for (int k = 0; k < 4; ++k) {
                const f32x4 w0 = *(const f32x4*)(cst + k * 128 + cq * 8), w1 = *(const f32x4*)(cst + k * 128 + cq * 8 + 4);
                const f32x2 wp0 = {w0[0], w0[1]}, wp1 = {w0[2], w0[3]}, wp2 = {w1[0], w1[1]}, wp3 = {w1[2], w1[3]};
#pragma unroll
                for (int i = 0; i < 2; ++i) {
                    const u32x4 v = pre.v[i][k];
                    a[i][0] = __builtin_elementwise_fma(wp0, (f32x2){__uint_as_float(v.x << 16), __uint_as_float(v.x & 0xffff0000u)}, a[i][0]);
                    a[i][1] = __builtin_elementwise_fma(wp1, (f32x2){__uint_as_float(v.y << 16), __uint_as_float(v.y & 0xffff0000u)}, a[i][1]);
                    a[i][2] = __builtin_elementwise_fma(wp2, (f32x2){__uint_as_float(v.z << 16), __uint_as_float(v.z & 0xffff0000u)}, a[i][2]);
                    a[i][3] = __builtin_elementwise_fma(wp3, (f32x2){__uint_as_float(v.w << 16), __uint_as_float(v.w & 0xffff0000u)}, a[i][3]);
                }
            }
#pragma unroll
            for (int i = 0; i < 2; ++i) {
                const int t = (tid >> 4) + 32 * i;
                u32x4 w; w.x = pkh(a[i][0].x, a[i][0].y); w.y = pkh(a[i][1].x, a[i][1].y); w.z = pkh(a[i][2].x, a[i][2].y); w.w = pkh(a[i][3].x, a[i][3].y);
                *(u32x4*)(xcb + t * 256 + ((cq ^ (t & 15)) << 4)) = w;
            }
        }
        const float hcar = pre.car;
        __syncthreads();
        if (it + (int)gridDim.x < nitems) scan_prefetch<PASS>(pre, p, xr, it + gridDim.x, tid);
        float bgv[3][8];
        if constexpr (PASS == 1) {
            const int k3 = 3 * ((it - (int)blockIdx.x) / (int)gridDim.x);
#pragma unroll
            for (int j = 0; j < 3; ++j) { const BgTile bt = bg_tile(p, (k3 + j) * (int)gridDim.x + (int)blockIdx.x, bgl); bg_load(bt, bgv[j]); }
            __builtin_amdgcn_sched_barrier(0);
        }
        u32x2 ggv[4];
        if constexpr (PASS == 2) {
#pragma unroll
            for (int i = 0; i < 4; ++i) ggv[i] = *(const u32x2*)(gg + (size_t)(row0 + i * 16 + (tid >> 5)) * 1024 + ch0 + (tid & 31) * 4);
        }
        {
#pragma unroll 1
            for (int mhr = 0; mhr < 2 * (PASS == 1 ? REP_GEMM : 1); ++mhr) {
                const int mh = mhr & 1;
                f32x4 acc[2][4];
#pragma unroll
                for (int m = 0; m < 2; ++m)
#pragma unroll
                    for (int n = 0; n < 4; ++n) acc[m][n] = (f32x4){0.f, 0.f, 0.f, 0.f};
#pragma unroll
                for (int kk = 0; kk < 4; ++kk) {
                    bf16x8 xf[2];
#pragma unroll
                    for (int m = 0; m < 2; ++m) xf[m] = *(const bf16x8*)(xcb + ((mh * 2 + m) * 16 + fr) * 256 + (((kk * 4 + fq) ^ fr) << 4));
#pragma unroll
                    for (int m = 0; m < 2; ++m)
#pragma unroll
                        for (int n = 0; n < 4; ++n) acc[m][n] = MFMA16H(wf[n][kk], xf[m], acc[m][n]);
                }
#pragma unroll
                for (int pr = 0; pr < 2; ++pr) {
                    const int chl = q * 32 + pr * 16 + fq * 4;
                    const f32x4 bav = *(const f32x4*)(cst + (5 + 2 * d) * 128 + chl), bxv = *(const f32x4*)(cst + (6 + 2 * d) * 128 + chl), c8v = *(const f32x4*)(cst + (9 + d) * 128 + chl);
#pragma unroll
                    for (int m = 0; m < 2; ++m) {
                        u32x4 w;
#pragma unroll
                        for (int k2 = 0; k2 < 2; ++k2) {
                            const f32x2 NL = {-LOG2E, -LOG2E}, ONE = {1.f, 1.f};
                            const f32x2 ar = {acc[m][pr][2 * k2], acc[m][pr][2 * k2 + 1]}, ai = {acc[m][2 + pr][2 * k2], acc[m][2 + pr][2 * k2 + 1]};
                            const f32x2 nb = {bav[2 * k2], bav[2 * k2 + 1]}, nx = {bxv[2 * k2], bxv[2 * k2 + 1]}, c8 = {c8v[2 * k2], c8v[2 * k2 + 1]};
                            const f32x2 zr = __builtin_elementwise_fma(ar, NL, nb), zi = __builtin_elementwise_fma(ai, NL, nx);
                            const f32x2 d1 = (f32x2){__builtin_amdgcn_exp2f(zr.x), __builtin_amdgcn_exp2f(zr.y)} + ONE, d2 = (f32x2){__builtin_amdgcn_exp2f(zi.x), __builtin_amdgcn_exp2f(zi.y)} + ONE;
                            const f32x2 r = {__builtin_amdgcn_rcpf(d1.x), __builtin_amdgcn_rcpf(d1.y)}, ig = {__builtin_amdgcn_rcpf(d2.x), __builtin_amdgcn_rcpf(d2.y)};
                            const f32x2 x = c8 * r;
                            const f32x2 a = {__builtin_amdgcn_exp2f(x.x), __builtin_amdgcn_exp2f(x.y)};
                            const f32x2 om = ONE - a, t = __builtin_elementwise_fma(om, a, om);
                            const f32x2 g = (f32x2){__builtin_amdgcn_sqrtf(t.x), __builtin_amdgcn_sqrtf(t.y)} * ig;
                            w[2 * k2] = pkh(om.x, g.x); w[2 * k2 + 1] = pkh(om.y, g.y);
                        }
                        *(u32x4*)(lds + SC_GI + (d * 64 + (mh * 2 + m) * 16 + fr) * 512 + (((chl >> 2) ^ (fr & 7)) << 4)) = w;
                    }
                }
            }
        }
        __syncthreads();
        if constexpr (PASS == 1) {
          const int ch = q * 32 + (lane & 31), half = lane >> 5;
          const float c8 = cst[(9 + d) * 128 + ch];
#pragma unroll 1
          for (int rep = 0; rep < REP_SCAN; ++rep) {
            float A = 1.f, B = 0.f;
            const char* gbase = lds + SC_GI + (d * 64 + half * 32) * 512 + (ch & 3) * 4;
            const char* xbase = xcb + (half * 32) * 256 + (ch & 7) * 2;
#define SCAN1_STEP(UPD)                                                                                                   \
            _Pragma("unroll") for (int s = 0; s < 32; ++s) {                                                              \
                const unsigned v = *(const unsigned*)(gbase + s * 512 + (((ch >> 2) ^ (s & 7)) << 4));                     \
                const unsigned x = *(const unsigned short*)(xbase + s * 256 + (((ch >> 3) ^ (s & 15)) << 4));              \
                const float a = mix_a(v);                                                                                  \
                const float bb = mix_gx(v, x);                                                                             \
                UPD                                                                                                        \
            }
            if (d == 0) { SCAN1_STEP(B = a * B + bb; A *= a;) } else { SCAN1_STEP(B += A * bb; A *= a;) }
#undef SCAN1_STEP
            const float A1 = __shfl_xor(A, 32), B1 = __shfl_xor(B, 32);
            if (half == 0) {
                float At, Bt;
                if (d == 0) { At = A * A1; Bt = A1 * B + B1; } else { At = A * A1; Bt = B + A * B1; }
                (d == 0 ? aggF : aggB)[(size_t)(b * NCH + c) * 1024 + ch0 + ch] = make_float2(At, Bt);
            }
          }
          {
            __builtin_amdgcn_sched_barrier(0);
            const int k3 = 3 * ((it - (int)blockIdx.x) / (int)gridDim.x);
#pragma unroll
            for (int j = 0; j < 3; ++j) { const BgTile bt = bg_tile(p, (k3 + j) * (int)gridDim.x + (int)blockIdx.x, bgl); bg_store(bt, bgv[j]); }
          }
        } else {
            if (tid < 256) {
                const int dd = __builtin_amdgcn_readfirstlane(tid >> 7), ch = tid & 127;
                float h = hcar;
                char* gbase = lds + SC_GI + dd * 64 * 512 + (ch & 3) * 4;
                const char* xbase = xcb + (ch & 7) * 2;
#define SCAN2_GO(t) (gbase + (t) * 512 + (((ch >> 2) ^ ((t) & 7)) << 4))
#define SCAN2_XO(t) (xbase + (t) * 256 + (((ch >> 3) ^ ((t) & 15)) << 4))
#define SCAN2_DIR(TOF)                                                                                                        \
                {                                                                                                             \
                    unsigned v[2][8], x[2][8];                                                                          \
                    _Pragma("unroll") for (int j = 0; j < 8; ++j) { const int t = TOF(j); v[0][j] = *(const unsigned*)SCAN2_GO(t); x[0][j] = *(const unsigned short*)SCAN2_XO(t); } \
                    _Pragma("unroll") for (int sb = 0; sb < 8; ++sb) {                                                        \
                        if (sb < 7) {                                                                                         \
                            _Pragma("unroll") for (int j = 0; j < 8; ++j) { const int t = TOF((sb + 1) * 8 + j); v[(sb + 1) & 1][j] = *(const unsigned*)SCAN2_GO(t); x[(sb + 1) & 1][j] = *(const unsigned short*)SCAN2_XO(t); } \
                        }                                                                                                     \
                        float hh[8];                                                                                          \
                        _Pragma("unroll") for (int j = 0; j < 8; ++j) {                                                       \
                            h = __builtin_fmaf(mix_a(v[sb & 1][j]), h, mix_gx(v[sb & 1][j], x[sb & 1][j])); hh[j] = h;         \
                        }                                                                                                     \
                        _Pragma("unroll") for (int j = 0; j < 8; ++j) { const int t = TOF(sb * 8 + j); *(float*)SCAN2_GO(t) = hh[j]; } \
                    }                                                                                                         \
                }
#define SCAN2_FWD(s) (s)
#define SCAN2_BWD(s) (63 - (s))
                if (dd == 0) SCAN2_DIR(SCAN2_FWD) else SCAN2_DIR(SCAN2_BWD)
#undef SCAN2_DIR
#undef SCAN2_FWD
#undef SCAN2_BWD
#undef SCAN2_GO
#undef SCAN2_XO
            }
            __syncthreads();
#pragma unroll
            for (int i = 0; i < 4; ++i) {
                const int t = i * 16 + (tid >> 5), c4 = (tid & 31) * 4;
                const int so = t * 512 + (((tid & 31) ^ (t & 7)) << 4);
                const f32x4 hf = *(const f32x4*)(lds + SC_GI + so), hb = *(const f32x4*)(lds + SC_GI + 64 * 512 + so);
                const size_t go = (size_t)(row0 + t) * 1024 + ch0 + c4;
                const u32x2 g2 = ggv[i];
                f32x4 o;
                o[0] = (hf[0] + hb[0]) * __uint_as_float(g2.x << 16); o[1] = (hf[1] + hb[1]) * __uint_as_float(g2.x & 0xffff0000u);
                o[2] = (hf[2] + hb[2]) * __uint_as_float(g2.y << 16); o[3] = (hf[3] + hb[3]) * __uint_as_float(g2.y & 0xffff0000u);
                *(u32x2*)(yb + go) = pk4(o);
            }
        }
    }
}
__device__ __forceinline__ void phase_carry(const Params& p, char* lds) {
    const int tid = tidx(), seg = tid >> 6, chl = tid & 63;
    float2* sagg = (float2*)lds;
    for (int it = blockIdx.x; it < 64; it += gridDim.x) {
        const int dir = it >> 5, b = (it >> 4) & 1, ch = (it & 15) * 64 + chl;
        const float2* agg = (const float2*)(p.ws + OFF_RS + (dir == 0 ? S_AGGF : S_AGGB));
        float* car = (float*)(p.ws + OFF_RS + (dir == 0 ? S_CARF : S_CARB));
        float2 ab[16];
#pragma unroll
        for (int j = 0; j < 16; ++j) { const int w = seg * 16 + j, c = dir == 0 ? w : NCH - 1 - w; ab[j] = agg[(size_t)(b * NCH + c) * 1024 + ch]; }
        float A = 1.f, B = 0.f;
#pragma unroll
        for (int j = 0; j < 16; ++j) { B = ab[j].x * B + ab[j].y; A *= ab[j].x; }
        sagg[seg * 64 + chl] = make_float2(A, B);
        __syncthreads();
        float h = 0.f;
        for (int sg = 0; sg < seg; ++sg) { const float2 sa = sagg[sg * 64 + chl]; h = sa.x * h + sa.y; }
#pragma unroll
        for (int j = 0; j < 16; ++j) { const int w = seg * 16 + j, c = dir == 0 ? w : NCH - 1 - w; car[(size_t)(b * NCH + c) * 1024 + ch] = h; h = ab[j].x * h + ab[j].y; }
        __syncthreads();
    }
}

constexpr bool PG8_IN0 = true;
constexpr int NPTR = (int)(sizeof(Params) / 8);
struct KArgs { __attribute__((address_space(1))) char* a[NPTR]; };
typedef const __attribute__((address_space(4))) KArgs* KParams;
template <int PH> __device__ __forceinline__ void run_phase(KParams kp, char* lds) {
    asm volatile("" : "+s"(kp));
    Params p;
    {
        char** pp = (char**)&p;
#pragma unroll
        for (int i = 0; i < NPTR; ++i) pp[i] = (char*)kp->a[i];
    }
    bf16_t* ra = (bf16_t*)(p.ws + OFF_RA); float* rf = (float*)(p.ws + OFF_RF);
    if constexpr (PH == 0) phase_prologue(p, lds);
    else if constexpr (PH == 1) phase_prologue2(p, lds);
    else if constexpr (PH == 2) phase_in0(p, lds);
    else if constexpr (PH == 3) phase_up(p, lds);
    else if constexpr (PH == 4) phase_attn(p, lds);
    else if constexpr (PH == 5) phase_outproj(p, lds, (const bf16_t*)(p.ws + OFF_RS + S_CAT), (const bf16_t*)(p.ws + OFF_WS + W_OUT0), ra, (bf16_t*)p.out);
    else if constexpr (PH == 6) phase_ln_router(p, lds, (const bf16_t*)p.out, ra, p.l0_ln1_g, p.l0_ln1_b, 0);
    else if constexpr (PH == 7) phase_moe(p, lds, 0, 0);
    else if constexpr (PH == 8) phase_moe(p, lds, 0, 1);
    else if constexpr (PH == 9) phase_ln2(p, ra, nullptr, ra, p.l0_ln2_g, p.l0_ln2_b);
    else if constexpr (PH == 10) phase_in1(p, lds);
    else if constexpr (PH == 11) phase_scan<1>(p, lds);
    else if constexpr (PH == 12) phase_carry(p, lds);
    else if constexpr (PH == 13) phase_scan<2>(p, lds);
    else if constexpr (PH == 14) phase_outproj(p, lds, (const bf16_t*)(p.ws + OFF_RS + S_XC), (const bf16_t*)(p.ws + OFF_WS + W_OUT1), ra, (bf16_t*)p.out);
    else if constexpr (PH == 15) {
        if (3 * ((2 * NCH * 8) / (int)gridDim.x) * (int)gridDim.x < BG_TILES || (2 * NCH * 8) % (int)gridDim.x != 0)
            for (int id = blockIdx.x; id < 3 * TC_MOE; id += gridDim.x) conv_moe(p, lds, id, 1);
        __syncthreads();
        phase_ln_router(p, lds, (const bf16_t*)p.out, ra, p.l1_ln1_g, p.l1_ln1_b, 1);
    }
    else if constexpr (PH == 16) phase_moe(p, lds, 1, 0);
    else if constexpr (PH == 17) phase_moe(p, lds, 1, 1);
    else if constexpr (PH == 18) phase_ln2(p, ra, p.out, nullptr, p.l1_ln2_g, p.l1_ln2_b);
}

#define XB_TMO      128
#define XB_XCNT(j)  (256  + 64 * (j))
#define XB_XSUB(j)  (1280 + 64 * (j))
#define XB_XGEN(j)  (2304 + 64 * (j))
#define XB_TOP      3328
#define XB_TOPGEN   3392
#define XCD_BAR_WORDS 3456
#define XB_SPIN_CAP (1u << 20)
__device__ __forceinline__ unsigned xb_ld(unsigned* p)              { return __hip_atomic_load(p, __ATOMIC_RELAXED, __HIP_MEMORY_SCOPE_AGENT); }
__device__ __forceinline__ unsigned xb_add(unsigned* p, unsigned v) { return __hip_atomic_fetch_add(p, v, __ATOMIC_RELAXED, __HIP_MEMORY_SCOPE_AGENT); }
__device__ __forceinline__ unsigned xb_xcc_id() { return (unsigned)__builtin_amdgcn_s_getreg((3 << 11) | 20) & 0xFu; }
#define XB_SPIN(cond, bar) do { unsigned _sp = 0; while (cond) { __builtin_amdgcn_s_sleep(1); \
    if ((++_sp & 255u) == 0u) { if (xb_ld(&(bar)[XB_TMO])) break; if (_sp > XB_SPIN_CAP) { atomicAdd(&(bar)[XB_TMO], 1u); break; } } } } while (0)
struct XcdBarrier { unsigned* bar; unsigned x; volatile LAS unsigned* st; };
__device__ __forceinline__ XcdBarrier xcd_barrier_post(unsigned* bar, volatile LAS unsigned* st) {
    XcdBarrier b; b.bar = bar; b.x = xb_xcc_id(); b.st = st;
    if (threadIdx.x == 0) (void)xb_add(&bar[XB_XCNT(b.x)], 1u);
    return b;
}
__device__ __forceinline__ void xcd_barrier_complete(unsigned* bar, unsigned x, unsigned& nloc, unsigned& nx) {
    const unsigned G = gridDim.x * gridDim.y * gridDim.z;
    unsigned sum, cnt, mine, sp = 0u;
    for (;;) {
        sum = 0u; cnt = 0u; mine = 0u;
#pragma unroll
        for (unsigned j = 0; j < 16; ++j) { const unsigned c = xb_ld(&bar[XB_XCNT(j)]); sum += c; cnt += (c > 0u) ? 1u : 0u; mine = (j == x) ? c : mine; }
        if (sum == G) break;
        __builtin_amdgcn_s_sleep(1);
        if ((++sp & 255u) == 0u) { if (xb_ld(&bar[XB_TMO])) break; if (sp > XB_SPIN_CAP) { atomicAdd(&bar[XB_TMO], 1u); break; } }
    }
    nloc = mine > 0u ? mine : 1u; nx = cnt > 0u ? cnt : 1u;
}
__device__ __forceinline__ void xcd_barrier(const XcdBarrier& b) {
    asm volatile("s_waitcnt vmcnt(0)" ::: "memory");
    __syncthreads();
    if (threadIdx.x == 0) {
        unsigned* bar = b.bar;
        __builtin_amdgcn_s_waitcnt(0);
        unsigned nloc = b.st[0], nx = b.st[1];
        if (nloc == 0u) { xcd_barrier_complete(bar, b.x, nloc, nx); b.st[0] = nloc; b.st[1] = nx; }
        const unsigned old = xb_add(&bar[XB_XSUB(b.x)], 1u);
        const unsigned gen = old / nloc;
        if (old + 1u == (gen + 1u) * nloc) {
            __builtin_amdgcn_fence(__ATOMIC_RELEASE, "agent");
            asm volatile("s_waitcnt vmcnt(0)" ::: "memory");
            const unsigned og = xb_add(&bar[XB_TOP], 1u);
            if (og + 1u == (og / nx + 1u) * nx) {
#pragma unroll
                for (unsigned j = 0; j < 16; ++j) __hip_atomic_fetch_add(&bar[XB_XGEN(j)], 1u, __ATOMIC_RELAXED, __HIP_MEMORY_SCOPE_AGENT);
            } else XB_SPIN(xb_ld(&bar[XB_XGEN(b.x)]) == gen, bar);
            __builtin_amdgcn_fence(__ATOMIC_ACQUIRE, "agent");
            asm volatile("s_waitcnt vmcnt(0)" ::: "memory");
        } else {
            XB_SPIN(xb_ld(&bar[XB_XGEN(b.x)]) == gen, bar);
            __builtin_amdgcn_fence(__ATOMIC_ACQUIRE, "agent");
            asm volatile("s_waitcnt vmcnt(0)" ::: "memory");
        }
    }
    __syncthreads();
}

constexpr unsigned NOBAR_MASK = 0u;
constexpr unsigned DUP_MASK = 0u;
template <int PH, int END> struct RunAll {
    static __device__ __forceinline__ void go(KParams kp, char* lds, const XcdBarrier& xb) {
        run_phase<PH>(kp, lds);
        if constexpr ((DUP_MASK >> PH) & 1u) { __syncthreads(); run_phase<PH>(kp, lds); }
        if constexpr (PH + 1 < END) { if constexpr (!((NOBAR_MASK >> PH) & 1u)) xcd_barrier(xb); RunAll<PH + 1, END>::go(kp, lds, xb); }
    }
};
__global__ void __launch_bounds__(NTHR) mega_kernel(KArgs ka) {
    extern __shared__ __attribute__((aligned(16))) char lds[];
    volatile LAS unsigned* st = (volatile LAS unsigned*)(LAS char*)(lds + LDS_BYTES);
    if (threadIdx.x == 0) { st[0] = 0u; st[1] = 0u; }
    __syncthreads();
    const XcdBarrier xb = xcd_barrier_post((unsigned*)((char*)ka.a[NPTR - 1] + OFF_MISC + M_BAR), st);
    RunAll<0, 19>::go((KParams)__builtin_amdgcn_kernarg_segment_ptr(), lds, xb);
}
}

extern "C" void kernel_launch(void* const* d_in, const int* in_sizes, int n_in, void* d_out, int out_size, void* d_ws, size_t ws_size, hipStream_t stream) {
    Params p{};
    const float** f = (const float**)&p;
    for (int i = 0; i < 39; ++i) f[i] = (const float*)d_in[i];
    p.out = (float*)d_out; p.ws = (char*)d_ws;
    if (ws_size < WS_NEED) fprintf(stderr, "workspace too small: %zu < %zu\n", ws_size, (size_t)WS_NEED);
    (void)hipMemsetAsync(p.ws + OFF_MISC, 0, 32768, stream);
    static int grid_blocks = 0;
    if (!grid_blocks) {
        (void)hipFuncSetAttribute((const void*)mega_kernel, hipFuncAttributeMaxDynamicSharedMemorySize, LDS_TOTAL);
        int dev = 0, cus = 0, per_cu = 0;
        (void)hipGetDevice(&dev);
        (void)hipDeviceGetAttribute(&cus, hipDeviceAttributeMultiprocessorCount, dev);
        (void)hipOccupancyMaxActiveBlocksPerMultiprocessor(&per_cu, mega_kernel, NTHR, LDS_TOTAL);
        if (per_cu > 1) per_cu = 1;
        grid_blocks = cus * per_cu;
        if (grid_blocks <= 0) { fprintf(stderr, "occupancy query failed: cus %d per_cu %d\n", cus, per_cu); grid_blocks = 256; }
    }
    void* args[] = {&p};
    hipError_t e = hipLaunchCooperativeKernel((const void*)mega_kernel, dim3(grid_blocks), dim3(NTHR), args, LDS_TOTAL, stream);
    if (e != hipSuccess) fprintf(stderr, "cooperative launch failed: %s (grid %d)\n", hipGetErrorString(e), grid_blocks);
}
```
